# Optimizing an MI355X kernel written in HIP

```python
import math
import jax, jax.numpy as jnp
from jax import lax
import numpy as np

D_MODEL = 1024
BATCH = 8
SEQ = 2048
DEPTH = 2

N_A_LAYERS = DEPTH // 2
N_B_LAYERS = DEPTH - N_A_LAYERS
DN_ALPHA = (2 * DEPTH) ** 0.25
DN_BETA = (8 * DEPTH) ** -0.25
LN_EPS = 1e-5

SSM_EXPAND = 2
SSM_D_INNER = SSM_EXPAND * D_MODEL
SSM_HEAD_DIM = 64
SSM_HEADS = SSM_D_INNER // SSM_HEAD_DIM
SSM_GROUPS = 4
SSM_STATE = 128
SSM_CONV = 4
SSM_CHUNK = 128
SSM_CONV_DIM = SSM_D_INNER + 2 * SSM_GROUPS * SSM_STATE
SSM_IN_DIM = SSM_D_INNER + SSM_CONV_DIM + SSM_HEADS

ATTN_HEAD_DIM = 64
ATTN_GROUPS = ((128, 1, 6), (512, 4, 5), (2048, 16, 5))
ATTN_HEADS = sum(g[2] for g in ATTN_GROUPS)
ATTN_WIDTH = ATTN_HEADS * ATTN_HEAD_DIM
ATTN_BLOCK = 128
N_BUCKETS = 32
MAX_DISTANCE = 2048

MOE_GROUPS = 4
MOE_EXPERTS_PER_GROUP = 8
MOE_TOP_K = 2
MOE_D_FF = 512

kernel_name = 'yoco_ssd_dilated_attn_hmoe'


def layer_norm(x, g, b):
    xf = x.astype(jnp.float32)
    mu = jnp.mean(xf, -1, keepdims=True)
    var = jnp.mean(jnp.square(xf - mu), -1, keepdims=True)
    return ((xf - mu) * lax.rsqrt(var + LN_EPS) * g.astype(jnp.float32) + b.astype(jnp.float32)).astype(x.dtype)


def causal_depthwise_conv(u, w, b):
    k, c = w.shape
    out = lax.conv_general_dilated(u, w[:, None, :], window_strides=(1,), padding=[(k - 1, 0)],
                                   dimension_numbers=('NWC', 'WIO', 'NWC'), feature_group_count=c)
    return out + b


def ssd_chunked(x, dt, a, bm, cm):
    b, s, h, p = x.shape
    g, n = bm.shape[2], bm.shape[3]
    r = h // g
    c = s // SSM_CHUNK
    xc = (x * dt[..., None].astype(x.dtype)).reshape(b, c, SSM_CHUNK, g, r, p)
    adt = (dt * a).reshape(b, c, SSM_CHUNK, g, r).transpose(0, 1, 3, 4, 2)
    acs = jnp.cumsum(adt, axis=-1)
    bc = bm.reshape(b, c, SSM_CHUNK, g, n)
    cc = cm.reshape(b, c, SSM_CHUNK, g, n)
    tri = np.tril(np.ones((SSM_CHUNK, SSM_CHUNK), dtype=bool))
    decay_in = jnp.exp(jnp.where(tri, acs[..., :, None] - acs[..., None, :], -jnp.inf))
    cb = jnp.einsum('bcign,bcjgn->bcgij', cc, bc)
    y_diag = jnp.einsum('bcgrij,bcjgrp->bcigrp', cb[:, :, :, None] * decay_in, xc)
    decay_states = jnp.exp(acs[..., -1:] - acs)
    states = jnp.einsum('bcjgn,bcgrj,bcjgrp->bcgrpn', bc, decay_states, xc)
    chunk_decay = jnp.exp(acs[..., -1])

    def step(carry, inp):
        st, dec = inp
        return carry * dec[..., None, None] + st, carry

    _, prev = lax.scan(step, jnp.zeros_like(states[:, 0]),
                       (jnp.swapaxes(states, 0, 1), jnp.swapaxes(chunk_decay, 0, 1)))
    prev = jnp.swapaxes(prev, 0, 1)
    y_off = jnp.einsum('bcign,bcgrpn,bcgri->bcigrp', cc, prev, jnp.exp(acs))
    return (y_diag + y_off).reshape(b, s, h, p)


def mamba2_mixer(h, in_w, conv_w, conv_b, dt_bias, a_log, d_skip, norm_w, out_w):
    bsz, s, _ = h.shape
    gn = SSM_GROUPS * SSM_STATE
    zxbcdt = h @ in_w
    z = zxbcdt[..., :SSM_D_INNER]
    xbc = zxbcdt[..., SSM_D_INNER:SSM_D_INNER + SSM_CONV_DIM]
    dt_raw = zxbcdt[..., SSM_D_INNER + SSM_CONV_DIM:]
    xbc = jax.nn.silu(causal_depthwise_conv(xbc, conv_w, conv_b))
    xs = xbc[..., :SSM_D_INNER].reshape(bsz, s, SSM_HEADS, SSM_HEAD_DIM)
    bm = xbc[..., SSM_D_INNER:SSM_D_INNER + gn].reshape(bsz, s, SSM_GROUPS, SSM_STATE)
    cm = xbc[..., SSM_D_INNER + gn:].reshape(bsz, s, SSM_GROUPS, SSM_STATE)
    dt = jax.nn.softplus(dt_raw.astype(jnp.float32) + dt_bias.astype(jnp.float32))
    a = -jnp.exp(a_log.astype(jnp.float32))
    y = ssd_chunked(xs, dt, a, bm, cm) + d_skip[:, None] * xs
    y = y.reshape(bsz, s, SSM_D_INNER) * jax.nn.silu(z)
    yg = y.astype(jnp.float32).reshape(bsz, s, SSM_GROUPS, -1)
    yg = yg * lax.rsqrt(jnp.mean(jnp.square(yg), -1, keepdims=True) + LN_EPS)
    y = (yg.reshape(bsz, s, SSM_D_INNER) * norm_w).astype(h.dtype)
    return y @ out_w


def t5_bucket(dist):
    max_exact = N_BUCKETS // 2
    n = np.maximum(dist, 1).astype(np.float64)
    large = max_exact + (np.log(n / max_exact) / np.log(MAX_DISTANCE / max_exact)
                         * (N_BUCKETS - max_exact)).astype(np.int32)
    large = np.minimum(large, N_BUCKETS - 1)
    return np.where(dist < max_exact, dist, large).astype(np.int32)


def dilated_group(q, k, v, bias_tab, window, dil):
    bsz, s, hg, dh = q.shape
    w_sub = window // dil
    l = s // dil
    nb = -(-l // ATTN_BLOCK)
    lp = nb * ATTN_BLOCK

    def split(t):
        return t.reshape(bsz, l, dil, hg, dh)

    qb = jnp.pad(split(q), ((0, 0), (0, lp - l), (0, 0), (0, 0), (0, 0))).reshape(bsz, nb, ATTN_BLOCK, dil, hg, dh)

    def kblocks(t):
        tp = jnp.pad(split(t), ((0, 0), (ATTN_BLOCK, lp - l), (0, 0), (0, 0), (0, 0)))
        tp = tp.reshape(bsz, nb + 1, ATTN_BLOCK, dil, hg, dh)
        return jnp.concatenate([tp[:, :-1], tp[:, 1:]], axis=2)

    kb, vb = kblocks(k), kblocks(v)
    sc = jnp.einsum('bnqrhe,bnkrhe->bnrhqk', qb, kb).astype(jnp.float32) * (ATTN_HEAD_DIM ** -0.5)
    delta = (np.arange(ATTN_BLOCK)[:, None] + ATTN_BLOCK) - np.arange(2 * ATTN_BLOCK)[None, :]
    band = (delta >= 0) & (delta <= w_sub)
    kpos = np.arange(nb)[:, None] * ATTN_BLOCK + np.arange(2 * ATTN_BLOCK)[None, :] - ATTN_BLOCK
    valid = band[None] & (kpos >= 0)[:, None, :]
    bucket = t5_bucket(np.clip(delta, 0, None) * dil)
    bias = jnp.transpose(bias_tab.astype(jnp.float32)[bucket], (2, 0, 1))
    sc = jnp.where(valid[None, :, None, None], sc + bias[None, None, None], -jnp.inf)
    m = jnp.max(sc, -1, keepdims=True)
    pr = jnp.exp(sc - m)
    den = jnp.sum(pr, -1)
    o = jnp.einsum('bnrhqk,bnkrhe->bnqrhe', pr.astype(v.dtype), vb)
    o = o / jnp.transpose(den, (0, 1, 4, 2, 3))[..., None]
    lse = jnp.transpose(m[..., 0] + jnp.log(den), (0, 1, 4, 2, 3))
    o = o.reshape(bsz, lp, dil, hg, dh)[:, :l].reshape(bsz, s, hg, dh)
    lse = lse.reshape(bsz, lp, dil, hg)[:, :l].reshape(bsz, s, hg)
    return o, lse


def dilated_attention(h, q_w, k_sh, v_sh, o_w, rel_bias):
    bsz, s, _ = h.shape
    q = (h @ q_w).reshape(bsz, s, ATTN_HEADS, ATTN_HEAD_DIM)
    outs, lses = [], []
    h0 = 0
    for window, dil, nh in ATTN_GROUPS:
        o, lse = dilated_group(q[:, :, h0:h0 + nh], k_sh[:, :, h0:h0 + nh], v_sh[:, :, h0:h0 + nh],
                               rel_bias[:, h0:h0 + nh], window, dil)
        outs.append(o)
        lses.append(jnp.mean(lse, -1))
        h0 += nh
    n_g = len(ATTN_GROUPS)
    wts = jax.nn.softmax(jnp.stack(lses, -1), -1) * n_g
    o = jnp.concatenate([outs[g] * wts[..., g, None, None] for g in range(n_g)], axis=2)
    return o.reshape(bsz, s, ATTN_WIDTH).astype(h.dtype) @ o_w


def hier_moe(h, group_w, group_b, expert_w, expert_b, gate_w, up_w, down_w):
    bsz, s, d = h.shape
    t = h.reshape(-1, d)
    g_logits = (t @ group_w).astype(jnp.float32) + group_b
    g_prob = jax.nn.softmax(g_logits, -1)
    g_idx = jnp.argmax(g_logits, -1)
    g_val = jnp.take_along_axis(g_prob, g_idx[:, None], -1)
    e_logits = jnp.einsum('nd,gde->nge', t, expert_w).astype(jnp.float32) + expert_b
    e_sel = jnp.take_along_axis(e_logits, g_idx[:, None, None], axis=1)[:, 0]
    top_v, top_i = lax.top_k(e_sel, MOE_TOP_K)
    top_p = jax.nn.softmax(top_v, -1) * g_val
    e_gate = jnp.sum(jax.nn.one_hot(top_i, MOE_EXPERTS_PER_GROUP, dtype=jnp.float32) * top_p[..., None], axis=1)
    gates = jax.nn.one_hot(g_idx, MOE_GROUPS, dtype=jnp.float32)[:, :, None] * e_gate[:, None, :]
    out = jnp.zeros((t.shape[0], d), jnp.float32)
    for g in range(MOE_GROUPS):
        hid = jax.nn.silu(jnp.einsum('nd,edf->nef', t, gate_w[g])) * jnp.einsum('nd,edf->nef', t, up_w[g])
        out = out + jnp.einsum('nef,efd->nd', hid * gates[:, g, :, None].astype(hid.dtype), down_w[g])
    return out.reshape(bsz, s, d).astype(h.dtype)


def setup_inputs(seed: int = 0) -> dict:
    key = jax.random.key(seed)
    ks = jax.random.split(key, 24)

    def nrm(k, shape, scale):
        return jax.random.normal(k, shape, jnp.float32) * scale

    na, nbl, L = N_A_LAYERS, N_B_LAYERS, DEPTH
    G, E, F = MOE_GROUPS, MOE_EXPERTS_PER_GROUP, MOE_D_FF
    x = nrm(ks[0], (BATCH, SEQ, D_MODEL), 1.0)
    ssm_in_w = nrm(ks[1], (na, D_MODEL, SSM_IN_DIM), D_MODEL ** -0.5)
    ssm_conv_w = nrm(ks[2], (na, SSM_CONV, SSM_CONV_DIM), SSM_CONV ** -0.5)
    ssm_conv_b = nrm(ks[3], (na, SSM_CONV_DIM), 0.02)
    dt0 = jnp.exp(jax.random.uniform(ks[4], (na, SSM_HEADS), jnp.float32, math.log(1e-3), math.log(1e-1)))
    ssm_dt_bias = dt0 + jnp.log(-jnp.expm1(-dt0))
    ssm_a_log = jnp.log(jax.random.uniform(ks[5], (na, SSM_HEADS), jnp.float32, 1.0, 16.0))
    ssm_d = 1.0 + nrm(ks[6], (na, SSM_HEADS), 0.1)
    ssm_norm_w = 1.0 + nrm(ks[7], (na, SSM_D_INNER), 0.05)
    ssm_out_w = nrm(ks[8], (na, SSM_D_INNER, D_MODEL), SSM_D_INNER ** -0.5 * DN_BETA)
    kv_w = jnp.concatenate([nrm(ks[9], (D_MODEL, ATTN_WIDTH), D_MODEL ** -0.5),
                            nrm(ks[10], (D_MODEL, ATTN_WIDTH), D_MODEL ** -0.5 * DN_BETA)], axis=1)
    attn_q_w = nrm(ks[11], (nbl, D_MODEL, ATTN_WIDTH), D_MODEL ** -0.5)
    attn_o_w = nrm(ks[12], (nbl, ATTN_WIDTH, D_MODEL), ATTN_WIDTH ** -0.5 * DN_BETA)
    rel_bias = nrm(ks[13], (N_BUCKETS, ATTN_HEADS), 0.5)
    moe_group_w = nrm(ks[14], (L, D_MODEL, G), D_MODEL ** -0.5)
    moe_group_b = nrm(ks[15], (L, G), 0.01)
    moe_expert_w = nrm(ks[16], (L, G, D_MODEL, E), D_MODEL ** -0.5)
    moe_expert_b = nrm(ks[17], (L, G, E), 0.01)
    moe_gate_w = nrm(ks[18], (L, G, E, D_MODEL, F), D_MODEL ** -0.5)
    moe_up_w = nrm(ks[19], (L, G, E, D_MODEL, F), D_MODEL ** -0.5 * DN_BETA)
    moe_down_w = nrm(ks[20], (L, G, E, F, D_MODEL), F ** -0.5 * DN_BETA)
    ln_g = 1.0 + nrm(ks[21], (L, 2, D_MODEL), 0.05)
    ln_b = nrm(ks[22], (L, 2, D_MODEL), 0.02)
    return {'x': x, 'ssm_in_w': ssm_in_w, 'ssm_conv_w': ssm_conv_w, 'ssm_conv_b': ssm_conv_b,
            'ssm_dt_bias': ssm_dt_bias, 'ssm_a_log': ssm_a_log, 'ssm_d': ssm_d, 'ssm_norm_w': ssm_norm_w,
            'ssm_out_w': ssm_out_w, 'kv_w': kv_w, 'attn_q_w': attn_q_w, 'attn_o_w': attn_o_w,
            'rel_bias': rel_bias, 'moe_group_w': moe_group_w, 'moe_group_b': moe_group_b,
            'moe_expert_w': moe_expert_w, 'moe_expert_b': moe_expert_b, 'moe_gate_w': moe_gate_w,
            'moe_up_w': moe_up_w, 'moe_down_w': moe_down_w, 'ln_g': ln_g, 'ln_b': ln_b}


def reference(x, ssm_in_w, ssm_conv_w, ssm_conv_b, ssm_dt_bias, ssm_a_log, ssm_d, ssm_norm_w,
              ssm_out_w, kv_w, attn_q_w, attn_o_w, rel_bias, moe_group_w, moe_group_b,
              moe_expert_w, moe_expert_b, moe_gate_w, moe_up_w, moe_down_w, ln_g, ln_b):
    bsz, s, _ = x.shape
    h = x
    k_sh = v_sh = None
    for i in range(DEPTH):
        if i < N_A_LAYERS:
            mix = mamba2_mixer(h, ssm_in_w[i], ssm_conv_w[i], ssm_conv_b[i], ssm_dt_bias[i],
                               ssm_a_log[i], ssm_d[i], ssm_norm_w[i], ssm_out_w[i])
        else:
            if i == N_A_LAYERS:
                kv = (h @ kv_w).reshape(bsz, s, 2, ATTN_HEADS, ATTN_HEAD_DIM)
                k_sh, v_sh = kv[:, :, 0], kv[:, :, 1]
            j = i - N_A_LAYERS
            mix = dilated_attention(h, attn_q_w[j], k_sh, v_sh, attn_o_w[j], rel_bias)
        h = layer_norm(DN_ALPHA * h + mix, ln_g[i, 0], ln_b[i, 0])
        ffn = hier_moe(h, moe_group_w[i], moe_group_b[i], moe_expert_w[i], moe_expert_b[i],
                       moe_gate_w[i], moe_up_w[i], moe_down_w[i])
        h = layer_norm(DN_ALPHA * h + ffn, ln_g[i, 1], ln_b[i, 1])
    return h
```

```cpp
#include <hip/hip_runtime.h>
#include <cstdio>
#include <cstdint>

constexpr int BATCH = 8, SEQ = 2048, DM = 1024, MTOK = BATCH * SEQ;
constexpr int DIN = 2048, NH = 32, HD = 64, NGRP = 4, NST = 128, CHK = 128, NCHK = SEQ / CHK, CONVD = 3072, INDIM = 5152, LDZ = 5376;
constexpr int ZX_X = 2048, ZX_B = 4096, ZX_C = 4608, ZX_DT = 5120;
constexpr int AH = 16, AD = 64;
constexpr int NEXP = 32, FF = 512, LISTCAP = MTOK;
constexpr float DN_ALPHA = 1.41421356237309515f, LN_EPS = 1e-5f;
constexpr int NPH = 18;

constexpr size_t MiB = 1u << 20;
constexpr size_t WS_CTL = 0, CTL_ZERO_BYTES = 1 * MiB;
constexpr size_t WS_LIST = 1 * MiB, WS_GLIST = 3 * MiB;
constexpr size_t WS_CD = 5 * MiB;
constexpr size_t WS_RW = 5 * MiB + 65536;
constexpr size_t WS_LSE = 6 * MiB;
constexpr size_t WS_INWT = 8 * MiB, WS_OUTWT = 19 * MiB, WS_QKVWT = 23 * MiB, WS_OWT = 29 * MiB;
constexpr size_t WS_GU0 = 32 * MiB, WS_DN0 = 96 * MiB, WS_GU1 = 128 * MiB, WS_DN1 = 192 * MiB;
constexpr size_t WS_XB = 224 * MiB, WS_ZX = 256 * MiB, WS_ST = 424 * MiB;
constexpr size_t WS_PRE1 = 224 * MiB, WS_H1 = 288 * MiB, WS_HB = 352 * MiB, WS_HID = 384 * MiB, WS_OUT2 = 424 * MiB;
constexpr size_t WS_H2 = 224 * MiB, WS_Q = 384 * MiB, WS_K = 416 * MiB, WS_V = 448 * MiB, WS_O = 480 * MiB, WS_PRE2 = 288 * MiB;
constexpr size_t WS_END = 512 * MiB;
constexpr int CW_BAR = 4096;
constexpr int CW_CNT = 16384;

constexpr int LDS_BYTES = 155648;
constexpr int MISC_OFF = 153600;

#define GAS __attribute__((address_space(1)))
#define LAS __attribute__((address_space(3)))
typedef unsigned short bf16;
typedef unsigned v4u __attribute__((ext_vector_type(4)));
typedef unsigned v2u __attribute__((ext_vector_type(2)));
typedef float f32x4 __attribute__((ext_vector_type(4)));
typedef short bf16x8 __attribute__((ext_vector_type(8)));

__device__ __forceinline__ float bf2f(unsigned v) { return __uint_as_float(v << 16); }
__device__ __forceinline__ float bflo(unsigned w) { return __uint_as_float(w << 16); }
__device__ __forceinline__ float bfhi(unsigned w) { return __uint_as_float(w & 0xffff0000u); }
__device__ __forceinline__ unsigned f2bf(float f) { unsigned u = __float_as_uint(f); return (u + 0x7fffu + ((u >> 16) & 1u)) >> 16; }
__device__ __forceinline__ unsigned pk2(float lo, float hi) { return f2bf(lo) | (f2bf(hi) << 16); }
__device__ __forceinline__ float silu_f(float x) { return x / (1.0f + __expf(-x)); }
__device__ __forceinline__ float softplus_f(float x) { return fmaxf(x, 0.f) + log1pf(__expf(-fabsf(x))); }
__device__ __forceinline__ float wave_sum(float v) {
#pragma unroll
    for (int o = 1; o < 64; o <<= 1) v += __shfl_xor(v, o);
    return v;
}

#define XB_TMO      128
#define XB_XCNT(j)  (256  + 64 * (j))
#define XB_XSUB(j)  (1280 + 64 * (j))
#define XB_XGEN(j)  (2304 + 64 * (j))
#define XB_TOP      3328
#define XB_TOPGEN   3392
#define XCD_BAR_WORDS 3456
#define XB_SPIN_CAP (1u << 22)

__device__ __forceinline__ unsigned xb_ld(unsigned* p)              { return __hip_atomic_load(p, __ATOMIC_RELAXED, __HIP_MEMORY_SCOPE_AGENT); }
__device__ __forceinline__ unsigned xb_add(unsigned* p, unsigned v) { return __hip_atomic_fetch_add(p, v, __ATOMIC_RELAXED, __HIP_MEMORY_SCOPE_AGENT); }
__device__ __forceinline__ unsigned xb_xcc_id() { return (unsigned)__builtin_amdgcn_s_getreg((3 << 11) | 20) & 0xFu; }
#define XB_SPIN(cond, bar) do { unsigned _sp = 0; while (cond) { __builtin_amdgcn_s_sleep(1); \
    if ((++_sp & 255u) == 0u) { if (xb_ld(&(bar)[XB_TMO])) break; if (_sp > XB_SPIN_CAP) { atomicAdd(&(bar)[XB_TMO], 1u); break; } } } } while (0)

struct XcdBarrier { unsigned* bar; unsigned x; volatile LAS unsigned* st; };

__device__ __forceinline__ XcdBarrier xcd_barrier_post(unsigned* bar, volatile LAS unsigned* st) {
    XcdBarrier b; b.bar = bar; b.x = xb_xcc_id(); b.st = st;
    if (threadIdx.x == 0) (void)xb_add(&bar[XB_XCNT(b.x)], 1u);
    return b;
}
__device__ __forceinline__ void xcd_barrier_complete(unsigned* bar, unsigned x, unsigned& nloc, unsigned& nx) {
    const unsigned G = gridDim.x * gridDim.y * gridDim.z;
    unsigned sum, cnt, mine, sp = 0u;
    for (;;) {
        sum = 0u; cnt = 0u; mine = 0u;
#pragma unroll
        for (unsigned j = 0; j < 16; ++j) { const unsigned c = xb_ld(&bar[XB_XCNT(j)]); sum += c; cnt += (c > 0u) ? 1u : 0u; mine = (j == x) ? c : mine; }
        if (sum == G) break;
        __builtin_amdgcn_s_sleep(1);
        if ((++sp & 255u) == 0u) { if (xb_ld(&bar[XB_TMO])) break; if (sp > XB_SPIN_CAP) { atomicAdd(&bar[XB_TMO], 1u); break; } }
    }
    nloc = mine > 0u ? mine : 1u; nx = cnt > 0u ? cnt : 1u;
}
__device__ __forceinline__ void xcd_barrier(const XcdBarrier& b) {
    asm volatile("s_waitcnt vmcnt(0)" ::: "memory");
    __syncthreads();
    if (threadIdx.x == 0) {
        unsigned* bar = b.bar;
        __builtin_amdgcn_s_waitcnt(0);
        unsigned nloc = b.st[0], nx = b.st[1];
        if (nloc == 0u) { xcd_barrier_complete(bar, b.x, nloc, nx); b.st[0] = nloc; b.st[1] = nx; }
        const unsigned old = xb_add(&bar[XB_XSUB(b.x)], 1u);
        const unsigned gen = old / nloc;
        if (old + 1u == (gen + 1u) * nloc) {
            __builtin_amdgcn_fence(__ATOMIC_RELEASE, "agent");
            asm volatile("s_waitcnt vmcnt(0)" ::: "memory");
            const unsigned og = xb_add(&bar[XB_TOP], 1u);
            const unsigned tg = og / nx;
            if (og + 1u == (tg + 1u) * nx) xb_add(&bar[XB_TOPGEN], 1u);
            else XB_SPIN(xb_ld(&bar[XB_TOPGEN]) == tg, bar);
            __builtin_amdgcn_fence(__ATOMIC_ACQUIRE, "agent");
            xb_add(&bar[XB_XGEN(b.x)], 1u);
            asm volatile("s_waitcnt vmcnt(0)" ::: "memory");
        } else {
            XB_SPIN(xb_ld(&bar[XB_XGEN(b.x)]) == gen, bar);
            __builtin_amdgcn_fence(__ATOMIC_ACQUIRE, "agent");
            asm volatile("s_waitcnt vmcnt(0)" ::: "memory");
        }
    }
    __syncthreads();
}

struct Frame {
    LAS unsigned char* lds;
    int tid, lane, wave, G, bid;
    const float* in[22];
    float* out;
    unsigned char* ws;
    unsigned* ctl;
};
#define WSP(T, off) ((T*)(F.ws + (off)))

__device__ __forceinline__ int t5_bucket(int dist) {
    if (dist < 16) return dist;
    int b = 16;
    b += dist >= 22; b += dist >= 30; b += dist >= 40; b += dist >= 54; b += dist >= 73; b += dist >= 99; b += dist >= 134; b += dist >= 182;
    b += dist >= 246; b += dist >= 332; b += dist >= 450; b += dist >= 609; b += dist >= 825; b += dist >= 1117; b += dist >= 1513;
    return b;
}

__device__ __forceinline__ void p0_transpose_item(const float* W, int N, int k0, int n0, bf16* WT, int ldt, int drow0, LAS float* scr, int lane) {
#pragma unroll 8
    for (int i = 0; i < 32; ++i) { const int kk = 2 * i + (lane >> 5); scr[kk * 33 + (lane & 31)] = W[(size_t)(k0 + kk) * N + n0 + (lane & 31)]; }
    asm volatile("s_waitcnt lgkmcnt(0)" ::: "memory");
    const int c = lane & 7;
#pragma unroll
    for (int j = 0; j < 4; ++j) { const int n = (lane >> 3) + 8 * j; const LAS float* s = scr + (8 * c) * 33 + n;
        v4u o; o.x = pk2(s[0 * 33], s[1 * 33]); o.y = pk2(s[2 * 33], s[3 * 33]); o.z = pk2(s[4 * 33], s[5 * 33]); o.w = pk2(s[6 * 33], s[7 * 33]);
        *(v4u*)(WT + (size_t)(drow0 + n) * ldt + k0 + 8 * c) = o; }
    asm volatile("s_waitcnt lgkmcnt(0)" ::: "memory");
}
__device__ __forceinline__ void p0_prologue(Frame& F) {
    LAS float* scr = (LAS float*)(F.lds + F.wave * 16384);
    const int gw = F.bid * 8 + F.wave, NGW = F.G * 8;
    constexpr int I_IN = 16 * 161, I_OUT = 32 * 32, I_KV = 16 * 64, I_Q = 16 * 32, I_O = 16 * 32, I_MOE = 2 * 32 * 256;
    constexpr int NITEMS = I_IN + I_OUT + I_KV + I_Q + I_O + 3 * I_MOE;
    for (int it = gw; it < NITEMS; it += NGW) {
        int r = it;
        if (r < I_IN) { const int kb = r / 161, nb = r % 161; p0_transpose_item(F.in[1], INDIM, kb * 64, nb * 32, WSP(bf16, WS_INWT), DM, nb * 32, scr, F.lane); continue; } r -= I_IN;
        if (r < I_OUT) { const int kb = r / 32, nb = r % 32; p0_transpose_item(F.in[8], DM, kb * 64, nb * 32, WSP(bf16, WS_OUTWT), DIN, nb * 32, scr, F.lane); continue; } r -= I_OUT;
        if (r < I_KV) { const int kb = r / 64, nb = r % 64; p0_transpose_item(F.in[9], 2048, kb * 64, nb * 32, WSP(bf16, WS_QKVWT), DM, 1024 + nb * 32, scr, F.lane); continue; } r -= I_KV;
        if (r < I_Q) { const int kb = r / 32, nb = r % 32; p0_transpose_item(F.in[10], DM, kb * 64, nb * 32, WSP(bf16, WS_QKVWT), DM, nb * 32, scr, F.lane); continue; } r -= I_Q;
        if (r < I_O) { const int kb = r / 32, nb = r % 32; p0_transpose_item(F.in[11], DM, kb * 64, nb * 32, WSP(bf16, WS_OWT), DM, nb * 32, scr, F.lane); continue; } r -= I_O;
        if (r < 2 * I_MOE) {
            const int isup = r / I_MOE; r -= isup * I_MOE;
            const int le = r / 256, q = r % 256, kb = q / 16, nb = q % 16, l = le / 32, e = le % 32;
            const float* W = F.in[isup ? 18 : 17] + (size_t)le * DM * FF;
            bf16* WT = WSP(bf16, l ? WS_GU1 : WS_GU0) + (size_t)e * 1024 * DM;
            const int n0 = nb * 32, drow0 = (n0 >> 7) * 256 + (n0 & 127) + isup * 128;
            p0_transpose_item(W, FF, kb * 64, n0, WT, DM, drow0, scr, F.lane); continue; }
        r -= 2 * I_MOE;
        { const int le = r / 256, q = r % 256, kb = q / 32, nb = q % 32, l = le / 32, e = le % 32;
          const float* W = F.in[19] + (size_t)le * FF * DM;
          bf16* WT = WSP(bf16, l ? WS_DN1 : WS_DN0) + (size_t)e * DM * FF;
          p0_transpose_item(W, DM, kb * 64, nb * 32, WT, FF, nb * 32, scr, F.lane); }
    }
    const int gt = F.bid * 512 + F.tid, NGT = F.G * 512;
    for (int i = gt; i < MTOK * DM / 8; i += NGT) {
        const f32x4 a = ((const f32x4*)F.in[0])[2 * i], b = ((const f32x4*)F.in[0])[2 * i + 1];
        v4u o; o.x = pk2(a.x, a.y); o.y = pk2(a.z, a.w); o.z = pk2(b.x, b.y); o.w = pk2(b.z, b.w);
        WSP(v4u, WS_XB)[i] = o;
    }
    for (int i = gt; i < (LDZ - INDIM) * DM / 8; i += NGT) (WSP(v4u, WS_INWT) + (size_t)INDIM * DM / 8)[i] = (v4u){0u, 0u, 0u, 0u};
}

__device__ __forceinline__ void dot4x2(const bf16* a0, const bf16* a1, const bf16* a2, const bf16* a3, const bf16* b0, const bf16* b1, int K, float (&acc)[4][2]) {
    for (int k = 0; k < K; k += 8) {
        const v4u A0 = *(const v4u*)(a0 + k), A1 = *(const v4u*)(a1 + k), A2 = *(const v4u*)(a2 + k), A3 = *(const v4u*)(a3 + k);
        const v4u B0 = *(const v4u*)(b0 + k), B1 = *(const v4u*)(b1 + k);
#pragma unroll
        for (int j = 0; j < 4; ++j) {
            const float b0l = bflo(B0[j]), b0h = bfhi(B0[j]), b1l = bflo(B1[j]), b1h = bfhi(B1[j]);
            acc[0][0] += bflo(A0[j]) * b0l + bfhi(A0[j]) * b0h; acc[0][1] += bflo(A0[j]) * b1l + bfhi(A0[j]) * b1h;
            acc[1][0] += bflo(A1[j]) * b0l + bfhi(A1[j]) * b0h; acc[1][1] += bflo(A1[j]) * b1l + bfhi(A1[j]) * b1h;
            acc[2][0] += bflo(A2[j]) * b0l + bfhi(A2[j]) * b0h; acc[2][1] += bflo(A2[j]) * b1l + bfhi(A2[j]) * b1h;
            acc[3][0] += bflo(A3[j]) * b0l + bfhi(A3[j]) * b0h; acc[3][1] += bflo(A3[j]) * b1l + bfhi(A3[j]) * b1h;
        }
    }
}
template <class Epi>
__device__ __forceinline__ void ref_gemm(Frame& F, const bf16* A, int lda, const bf16* Bt, int ldb, int M, int N, int K, const Epi& epi) {
    const int tx = F.tid & 63, ty = F.tid >> 6, ntn = N / 128, ntiles = (M / 32) * ntn;
    for (int t = F.bid; t < ntiles; t += F.G) {
        const int m0 = (t / ntn) * 32 + ty * 4, n0 = (t % ntn) * 128 + tx * 2;
        float acc[4][2] = {};
        const bf16* ap = A + (size_t)m0 * lda; const bf16* bp = Bt + (size_t)n0 * ldb;
        dot4x2(ap, ap + lda, ap + 2 * lda, ap + 3 * lda, bp, bp + ldb, K, acc);
#pragma unroll
        for (int r = 0; r < 4; ++r) epi(m0 + r, n0, acc[r][0], acc[r][1]);
    }
}

template <int MODE>
__device__ __forceinline__ void ref_ssd_chunk(Frame& F, int unit) {
    const int b = unit / (NCHK * NGRP), c = (unit / NGRP) % NCHK, g = unit % NGRP;
    const int hl = F.tid >> 6, p = F.tid & 63, h = g * 8 + hl, xch = h * 64 + p;
    const bf16* zx = WSP(bf16, WS_ZX);
    const float* cw = F.in[2]; const float* cbias = F.in[3];
    LAS float* bcL = (LAS float*)F.lds;
    LAS float* red = (LAS float*)(F.lds + 1024);
    float st[NST];
    const size_t sbase = ((size_t)((b * NCHK + c) * NH + h) * HD + p) * NST;
    bf16* stg = WSP(bf16, WS_ST);
    if (MODE == 1) {
#pragma unroll
        for (int n = 0; n < NST; n += 8) { const v4u v = *(const v4u*)(stg + sbase + n);
#pragma unroll
            for (int j = 0; j < 4; ++j) { st[n + 2 * j] = bflo(v[j]); st[n + 2 * j + 1] = bfhi(v[j]); } }
    } else {
#pragma unroll
        for (int n = 0; n < NST; ++n) st[n] = 0.f;
    }
    const int xcol = ZX_X + xch;
    const float xw0 = cw[0 * CONVD + xch], xw1 = cw[1 * CONVD + xch], xw2 = cw[2 * CONVD + xch], xw3 = cw[3 * CONVD + xch], xb_ = cbias[xch];
    const int bcch = (F.tid < 128) ? (2048 + g * 128 + F.tid) : (2048 + 512 + g * 128 + (F.tid - 128));
    const int bccol = ZX_X + bcch;
    float bw0 = 0, bw1 = 0, bw2 = 0, bw3 = 0, bb_ = 0;
    if (F.tid < 256) { bw0 = cw[0 * CONVD + bcch]; bw1 = cw[1 * CONVD + bcch]; bw2 = cw[2 * CONVD + bcch]; bw3 = cw[3 * CONVD + bcch]; bb_ = cbias[bcch]; }
    const float dtb = F.in[4][h], Acoef = -__expf(F.in[5][h]), Dh = F.in[6][h], nw = F.in[7][xch];
    const size_t row0 = (size_t)b * SEQ + (size_t)c * CHK;
    float x1 = 0, x2 = 0, x3 = 0, q1 = 0, q2 = 0, q3 = 0;
    if (c > 0) {
        x1 = bf2f(zx[(row0 - 1) * LDZ + xcol]); x2 = bf2f(zx[(row0 - 2) * LDZ + xcol]); x3 = bf2f(zx[(row0 - 3) * LDZ + xcol]);
        if (F.tid < 256) { q1 = bf2f(zx[(row0 - 1) * LDZ + bccol]); q2 = bf2f(zx[(row0 - 2) * LDZ + bccol]); q3 = bf2f(zx[(row0 - 3) * LDZ + bccol]); }
    }
    float asum = 0.f;
    for (int t = 0; t < CHK; ++t) {
        const size_t row = row0 + t;
        const float x0 = bf2f(zx[row * LDZ + xcol]);
        const float xv = silu_f(xb_ + xw0 * x3 + xw1 * x2 + xw2 * x1 + xw3 * x0);
        x3 = x2; x2 = x1; x1 = x0;
        if (F.tid < 256) { const float q0 = bf2f(zx[row * LDZ + bccol]); bcL[F.tid] = silu_f(bb_ + bw0 * q3 + bw1 * q2 + bw2 * q1 + bw3 * q0); q3 = q2; q2 = q1; q1 = q0; }
        const float dtv = softplus_f(bf2f(zx[row * LDZ + ZX_DT + h]) + dtb);
        const float adt = dtv * Acoef, dA = __expf(adt);
        asum += adt;
        __syncthreads();
        const float xs = dtv * xv;
        float y = 0.f;
#pragma unroll
        for (int n = 0; n < NST; ++n) { st[n] = st[n] * dA + xs * bcL[n]; if (MODE == 1) y += bcL[128 + n] * st[n]; }
        if (MODE == 1) {
            y += Dh * xv;
            y *= silu_f(bf2f(zx[row * LDZ + xch]));
            const float ws2 = wave_sum(y * y);
            if (F.lane == 0) red[hl] = ws2;
            __syncthreads();
            float tot = 0.f;
#pragma unroll
            for (int i = 0; i < 8; ++i) tot += red[i];
            const float rs = 1.0f / sqrtf(tot * (1.0f / 512.0f) + LN_EPS);
            ((bf16*)F.out)[row * DIN + xch] = (bf16)f2bf(y * rs * nw);
        }
        __syncthreads();
    }
    if (MODE == 0) {
#pragma unroll
        for (int n = 0; n < NST; n += 8) { v4u v;
#pragma unroll
            for (int j = 0; j < 4; ++j) v[j] = pk2(st[n + 2 * j], st[n + 2 * j + 1]);
            *(v4u*)(stg + sbase + n) = v; }
        if (p == 0) WSP(float, WS_CD)[(b * NCHK + c) * NH + h] = __expf(asum);
    }
}

__device__ __forceinline__ void p3_scan(Frame& F) {
    bf16* stg = WSP(bf16, WS_ST); const float* cd = WSP(float, WS_CD);
    const int gt = F.bid * 512 + F.tid, NGT = F.G * 512;
    for (int i = gt; i < BATCH * NH * HD * (NST / 8); i += NGT) {
        const int n8 = i & 15, p = (i >> 4) & 63, h = (i >> 10) & 31, b = i >> 15;
        float carry[8] = {0, 0, 0, 0, 0, 0, 0, 0};
        for (int c = 0; c < NCHK; ++c) {
            v4u* ptr = (v4u*)(stg + ((size_t)((b * NCHK + c) * NH + h) * HD + p) * NST + n8 * 8);
            const v4u s = *ptr; const float d = cd[(b * NCHK + c) * NH + h];
            v4u o;
#pragma unroll
            for (int j = 0; j < 4; ++j) { o[j] = pk2(carry[2 * j], carry[2 * j + 1]); carry[2 * j] = carry[2 * j] * d + bflo(s[j]); carry[2 * j + 1] = carry[2 * j + 1] * d + bfhi(s[j]); }
            *ptr = o;
        }
    }
}

__device__ __forceinline__ void ln_row(f32x4 (&v)[4], const float* g, const float* bta, int lane) {
    float s = 0.f;
#pragma unroll
    for (int j = 0; j < 4; ++j) s += (v[j].x + v[j].y) + (v[j].z + v[j].w);
    const float mean = wave_sum(s) * (1.f / DM); float s2 = 0.f;
#pragma unroll
    for (int j = 0; j < 4; ++j) { v[j] = v[j] - mean; s2 += (v[j].x * v[j].x + v[j].y * v[j].y) + (v[j].z * v[j].z + v[j].w * v[j].w); }
    const float rstd = 1.0f / sqrtf(wave_sum(s2) * (1.f / DM) + LN_EPS);
#pragma unroll
    for (int j = 0; j < 4; ++j) { const f32x4 gg = ((const f32x4*)g)[lane + 64 * j], bb = ((const f32x4*)bta)[lane + 64 * j]; v[j] = v[j] * rstd * gg + bb; }
}
__device__ __forceinline__ void store_row_f32_bf16(const f32x4 (&v)[4], float* of, bf16* ob, int lane) {
#pragma unroll
    for (int j = 0; j < 4; ++j) {
        if (of) ((f32x4*)of)[lane + 64 * j] = v[j];
        if (ob) ((v2u*)ob)[lane + 64 * j] = (v2u){pk2(v[j].x, v[j].y), pk2(v[j].z, v[j].w)};
    }
}

__device__ __forceinline__ void p_ln_router(Frame& F, int layer, const float* pre, float* hf, bf16* hb) {
    const float* lg = F.in[20] + (size_t)(layer * 2 + 0) * DM; const float* lb = F.in[21] + (size_t)(layer * 2 + 0) * DM;
    const float* gw = F.in[13] + (size_t)layer * DM * 4; const float* gb = F.in[14] + layer * 4;
    const float* ew = F.in[15] + (size_t)layer * 4 * DM * 8; const float* eb = F.in[16] + layer * 32;
    unsigned* cnt = F.ctl + CW_CNT + layer * 64 * 32;
    int* list = WSP(int, WS_LIST); float* glist = WSP(float, WS_GLIST);
    const int gwv = F.bid * 8 + F.wave, NGW = F.G * 8, lane = F.lane;
    for (int tok = gwv; tok < MTOK; tok += NGW) {
        f32x4 v[4];
#pragma unroll
        for (int j = 0; j < 4; ++j) v[j] = ((const f32x4*)(pre + (size_t)tok * DM))[lane + 64 * j];
        ln_row(v, lg, lb, lane);
        store_row_f32_bf16(v, hf + (size_t)tok * DM, hb + (size_t)tok * DM, lane);
        float gl[4] = {0, 0, 0, 0};
#pragma unroll
        for (int j = 0; j < 4; ++j)
#pragma unroll
            for (int i = 0; i < 4; ++i) { const int k = 4 * lane + 256 * j + i; const f32x4 w = ((const f32x4*)gw)[k]; const float hv = v[j][i];
                gl[0] += hv * w.x; gl[1] += hv * w.y; gl[2] += hv * w.z; gl[3] += hv * w.w; }
#pragma unroll
        for (int q = 0; q < 4; ++q) gl[q] = wave_sum(gl[q]) + gb[q];
        int gi = 0; float gm = gl[0];
#pragma unroll
        for (int q = 1; q < 4; ++q) if (gl[q] > gm) { gm = gl[q]; gi = q; }
        float gden = 0.f;
#pragma unroll
        for (int q = 0; q < 4; ++q) gden += __expf(gl[q] - gm);
        const float gval = 1.0f / gden;
        float el[8] = {0, 0, 0, 0, 0, 0, 0, 0};
        const float* ewg = ew + (size_t)gi * DM * 8;
#pragma unroll
        for (int j = 0; j < 4; ++j)
#pragma unroll
            for (int i = 0; i < 4; ++i) { const int k = 4 * lane + 256 * j + i; const f32x4 w0 = ((const f32x4*)ewg)[2 * k], w1 = ((const f32x4*)ewg)[2 * k + 1]; const float hv = v[j][i];
                el[0] += hv * w0.x; el[1] += hv * w0.y; el[2] += hv * w0.z; el[3] += hv * w0.w; el[4] += hv * w1.x; el[5] += hv * w1.y; el[6] += hv * w1.z; el[7] += hv * w1.w; }
#pragma unroll
        for (int q = 0; q < 8; ++q) el[q] = wave_sum(el[q]) + eb[gi * 8 + q];
        int i1 = 0; float v1 = el[0];
#pragma unroll
        for (int q = 1; q < 8; ++q) if (el[q] > v1) { v1 = el[q]; i1 = q; }
        int i2 = -1; float v2 = -3.0e38f;
#pragma unroll
        for (int q = 0; q < 8; ++q) if (q != i1 && el[q] > v2) { v2 = el[q]; i2 = q; }
        const float e2 = __expf(v2 - v1), p1 = gval / (1.0f + e2), p2 = gval * e2 / (1.0f + e2);
        if (lane == 0) {
            const int ea = gi * 8 + i1, ebx = gi * 8 + i2;
            const unsigned s1 = atomicAdd(cnt + ea * 64, 1u); list[ea * LISTCAP + s1] = tok * 2; glist[ea * LISTCAP + s1] = p1;
            const unsigned s2 = atomicAdd(cnt + ebx * 64, 1u); list[ebx * LISTCAP + s2] = tok * 2 + 1; glist[ebx * LISTCAP + s2] = p2;
        }
    }
}

struct MoeTab { volatile LAS int* ts; volatile LAS int* cn; };
__device__ __forceinline__ MoeTab moe_table(Frame& F, int layer) {
    MoeTab T; T.ts = (volatile LAS int*)(F.lds + MISC_OFF + 256); T.cn = (volatile LAS int*)(F.lds + MISC_OFF + 512);
    __syncthreads();
    if (F.tid == 0) { int acc = 0; for (int e = 0; e < NEXP; ++e) { const int c = (int)__hip_atomic_load(F.ctl + CW_CNT + layer * 64 * 32 + e * 64, __ATOMIC_RELAXED, __HIP_MEMORY_SCOPE_AGENT); T.cn[e] = c; T.ts[e] = acc; acc += (c + 255) >> 8; } T.ts[NEXP] = acc; }
    __syncthreads();
    return T;
}
__device__ __forceinline__ void moe_find(const MoeTab& T, int rt, int& e, int& j) { int ee = 0; while (ee < NEXP - 1 && T.ts[ee + 1] <= rt) ++ee; e = ee; j = rt - T.ts[ee]; }

__device__ __forceinline__ void ref_moe_gateup(Frame& F, int layer) {
    const MoeTab T = moe_table(F, layer);
    const bf16* hb = WSP(bf16, WS_HB); const bf16* gu = WSP(bf16, layer ? WS_GU1 : WS_GU0); bf16* hid = WSP(bf16, WS_HID);
    const int* list = WSP(int, WS_LIST); const float* glist = WSP(float, WS_GLIST);
    const int nunits = T.ts[NEXP] * 4, fl = F.tid & 127, ty = F.tid >> 7;
    for (int u = F.bid; u < nunits; u += F.G) {
        const int rt = u >> 2, pn = u & 3; int e, j; moe_find(T, rt, e, j);
        const int cnt = T.cn[e];
        const bf16* bg = gu + ((size_t)e * 1024 + pn * 256 + fl) * DM; const bf16* bu = bg + (size_t)128 * DM;
        for (int rr = ty * 4; rr < 256; rr += 16) {
            const bf16* ap[4]; float gv[4];
#pragma unroll
            for (int r = 0; r < 4; ++r) { const int slot = j * 256 + rr + r; const bool ok = slot < cnt; const int pair = ok ? list[e * LISTCAP + slot] : 0; gv[r] = ok ? glist[e * LISTCAP + slot] : 0.f; ap[r] = hb + (size_t)(pair >> 1) * DM; }
            float acc[4][2] = {};
            dot4x2(ap[0], ap[1], ap[2], ap[3], bg, bu, DM, acc);
#pragma unroll
            for (int r = 0; r < 4; ++r) hid[((size_t)rt * 256 + rr + r) * FF + pn * 128 + fl] = (bf16)f2bf(silu_f(acc[r][0]) * acc[r][1] * gv[r]);
        }
    }
}
__device__ __forceinline__ void ref_moe_down(Frame& F, int layer) {
    const MoeTab T = moe_table(F, layer);
    const bf16* hid = WSP(bf16, WS_HID); const bf16* dn = WSP(bf16, layer ? WS_DN1 : WS_DN0); bf16* out2 = WSP(bf16, WS_OUT2);
    const int* list = WSP(int, WS_LIST);
    const int nunits = T.ts[NEXP] * 4, tx = F.tid & 127, ty = F.tid >> 7;
    for (int u = F.bid; u < nunits; u += F.G) {
        const int rt = u >> 2, pn = u & 3; int e, j; moe_find(T, rt, e, j);
        const int cnt = T.cn[e];
        const bf16* b0 = dn + ((size_t)e * DM + pn * 256 + tx * 2) * FF; const bf16* b1 = b0 + FF;
        for (int rr = ty * 4; rr < 256; rr += 16) {
            const bf16* a0 = hid + ((size_t)rt * 256 + rr) * FF;
            float acc[4][2] = {};
            dot4x2(a0, a0 + FF, a0 + 2 * FF, a0 + 3 * FF, b0, b1, FF, acc);
#pragma unroll
            for (int r = 0; r < 4; ++r) { const int slot = j * 256 + rr + r; if (slot < cnt) { const int pair = list[e * LISTCAP + slot];
                *(unsigned*)(out2 + (size_t)pair * DM + pn * 256 + tx * 2) = pk2(acc[r][0], acc[r][1]); } }
        }
    }
}
__device__ __forceinline__ void p_ln_ffn(Frame& F, int layer, const float* hf, float* of, bf16* ob) {
    const float* lg = F.in[20] + (size_t)(layer * 2 + 1) * DM; const float* lb = F.in[21] + (size_t)(layer * 2 + 1) * DM;
    const bf16* out2 = WSP(bf16, WS_OUT2);
    const int gwv = F.bid * 8 + F.wave, NGW = F.G * 8, lane = F.lane;
    for (int tok = gwv; tok < MTOK; tok += NGW) {
        f32x4 v[4];
#pragma unroll
        for (int j = 0; j < 4; ++j) {
            const f32x4 hv = ((const f32x4*)(hf + (size_t)tok * DM))[lane + 64 * j];
            const v2u a = ((const v2u*)(out2 + (size_t)(2 * tok) * DM))[lane + 64 * j], b = ((const v2u*)(out2 + (size_t)(2 * tok + 1) * DM))[lane + 64 * j];
            v[j].x = DN_ALPHA * hv.x + (bflo(a.x) + bflo(b.x)); v[j].y = DN_ALPHA * hv.y + (bfhi(a.x) + bfhi(b.x));
            v[j].z = DN_ALPHA * hv.z + (bflo(a.y) + bflo(b.y)); v[j].w = DN_ALPHA * hv.w + (bfhi(a.y) + bfhi(b.y));
        }
        ln_row(v, lg, lb, lane);
        store_row_f32_bf16(v, of + (size_t)tok * DM, ob ? ob + (size_t)tok * DM : nullptr, lane);
    }
}

__device__ __forceinline__ void ref_attention(Frame& F) {
    const bf16* Q = WSP(bf16, WS_Q); const bf16* Kb = WSP(bf16, WS_K); const bf16* Vb = WSP(bf16, WS_V); bf16* O = WSP(bf16, WS_O); float* lse = WSP(float, WS_LSE);
    const float* relb = F.in[12];
    const int gt = F.bid * 512 + F.tid, NGT = F.G * 512;
    for (int i = gt; i < MTOK * AH; i += NGT) {
        const int hd = i & 15, row = i >> 4, t = row & (SEQ - 1), rb = row - t;
        const int dil = hd < 6 ? 1 : (hd < 11 ? 4 : 16);
        float q[AD], o[AD];
#pragma unroll
        for (int d = 0; d < AD; d += 8) { const v4u v = *(const v4u*)(Q + (size_t)row * DM + hd * AD + d);
#pragma unroll
            for (int j = 0; j < 4; ++j) { q[d + 2 * j] = bflo(v[j]); q[d + 2 * j + 1] = bfhi(v[j]); } }
#pragma unroll
        for (int d = 0; d < AD; ++d) o[d] = 0.f;
        float m = -3.0e38f, l = 0.f;
        for (int delta = 0; delta <= 128; ++delta) {
            const int kt = t - delta * dil; if (kt < 0) break;
            const size_t kr = (size_t)(rb + kt) * DM + hd * AD;
            float s = 0.f;
#pragma unroll
            for (int d = 0; d < AD; d += 8) { const v4u v = *(const v4u*)(Kb + kr + d);
#pragma unroll
                for (int j = 0; j < 4; ++j) s += q[d + 2 * j] * bflo(v[j]) + q[d + 2 * j + 1] * bfhi(v[j]); }
            s = s * 0.125f + relb[t5_bucket(delta * dil) * AH + hd];
            const float mn = fmaxf(m, s), sc = __expf(m - mn), pw = __expf(s - mn);
            l = l * sc + pw; m = mn;
#pragma unroll
            for (int d = 0; d < AD; d += 8) { const v4u v = *(const v4u*)(Vb + kr + d);
#pragma unroll
                for (int j = 0; j < 4; ++j) { o[d + 2 * j] = o[d + 2 * j] * sc + pw * bflo(v[j]); o[d + 2 * j + 1] = o[d + 2 * j + 1] * sc + pw * bfhi(v[j]); } }
        }
        const float inv = 1.0f / l;
#pragma unroll
        for (int d = 0; d < AD; d += 8) { v4u v;
#pragma unroll
            for (int j = 0; j < 4; ++j) v[j] = pk2(o[d + 2 * j] * inv, o[d + 2 * j + 1] * inv);
            *(v4u*)(O + (size_t)row * DM + hd * AD + d) = v; }
        lse[(size_t)row * AH + hd] = m + __logf(l);
    }
}
__device__ __forceinline__ void p_attn_rescale(Frame& F) {
    bf16* O = WSP(bf16, WS_O); const float* lse = WSP(float, WS_LSE);
    const int gwv = F.bid * 8 + F.wave, NGW = F.G * 8, lane = F.lane;
    for (int row = gwv; row < MTOK; row += NGW) {
        const float lv = lane < 16 ? lse[(size_t)row * AH + lane] : 0.f;
        float s0 = 0.f, s1 = 0.f, s2 = 0.f;
#pragma unroll
        for (int hh = 0; hh < 16; ++hh) { const float x = __shfl(lv, hh); if (hh < 6) s0 += x; else if (hh < 11) s1 += x; else s2 += x; }
        s0 *= (1.f / 6.f); s1 *= 0.2f; s2 *= 0.2f;
        const float mx = fmaxf(s0, fmaxf(s1, s2)), e0 = __expf(s0 - mx), e1 = __expf(s1 - mx), e2 = __expf(s2 - mx), inv = 3.0f / (e0 + e1 + e2);
        const int hd = lane >> 2; const float w = (hd < 6 ? e0 : (hd < 11 ? e1 : e2)) * inv;
        v4u* p = (v4u*)(O + (size_t)row * DM + lane * 16);
#pragma unroll
        for (int c = 0; c < 2; ++c) { v4u v = p[c];
#pragma unroll
            for (int j = 0; j < 4; ++j) v[j] = pk2(bflo(v[j]) * w, bfhi(v[j]) * w);
            p[c] = v; }
    }
}

struct Args { const float* in[22]; float* out; unsigned char* ws; int ph_lo, ph_hi; };

__global__ void __launch_bounds__(512, 2) mk_fwd(Args a) {
    extern __shared__ __attribute__((aligned(16))) unsigned char lds_raw[];
    Frame F;
    F.lds = (LAS unsigned char*)lds_raw;
    F.tid = threadIdx.x; F.lane = F.tid & 63; F.wave = __builtin_amdgcn_readfirstlane(F.tid >> 6); F.G = gridDim.x; F.bid = blockIdx.x;
#pragma unroll
    for (int i = 0; i < 22; ++i) F.in[i] = a.in[i];
    F.out = a.out; F.ws = a.ws; F.ctl = (unsigned*)(a.ws + WS_CTL);
    volatile LAS unsigned* MISC = (volatile LAS unsigned*)(F.lds + MISC_OFF);
    if (F.tid < 64) MISC[F.tid] = 0u;
    __syncthreads();
    const bool one_launch = (a.ph_lo == 0 && a.ph_hi == NPH);
    XcdBarrier bar; bar.bar = F.ctl + CW_BAR; bar.x = 0; bar.st = MISC + 8;
    if (one_launch) bar = xcd_barrier_post(F.ctl + CW_BAR, MISC + 8);
    const int lo = a.ph_lo, hi = a.ph_hi;
#define IN(k) (lo <= (k) && (k) < hi)
#define SEAM(k) do { if (IN(k) && IN((k) + 1)) xcd_barrier(bar); } while (0)

    if (IN(0)) { p0_prologue(F); } SEAM(0);
    if (IN(1)) {
        bf16* zx = WSP(bf16, WS_ZX);
        ref_gemm(F, WSP(bf16, WS_XB), DM, WSP(bf16, WS_INWT), DM, MTOK, LDZ, DM, [=](int m, int n, float v0, float v1) { *(unsigned*)(zx + (size_t)m * LDZ + n) = pk2(v0, v1); });
    } SEAM(1);
    if (IN(2)) { for (int u = F.bid; u < BATCH * NCHK * NGRP; u += F.G) ref_ssd_chunk<0>(F, u); } SEAM(2);
    if (IN(3)) { p3_scan(F); } SEAM(3);
    if (IN(4)) { for (int u = F.bid; u < BATCH * NCHK * NGRP; u += F.G) ref_ssd_chunk<1>(F, u); } SEAM(4);
    if (IN(5)) {
        float* pre = WSP(float, WS_PRE1); const float* x = F.in[0];
        ref_gemm(F, (const bf16*)F.out, DIN, WSP(bf16, WS_OUTWT), DIN, MTOK, DM, DIN, [=](int m, int n, float v0, float v1) { const size_t o = (size_t)m * DM + n; pre[o] = DN_ALPHA * x[o] + v0; pre[o + 1] = DN_ALPHA * x[o + 1] + v1; });
    } SEAM(5);
    if (IN(6)) { p_ln_router(F, 0, WSP(float, WS_PRE1), WSP(float, WS_H1), WSP(bf16, WS_HB)); } SEAM(6);
    if (IN(7)) { ref_moe_gateup(F, 0); } SEAM(7);
    if (IN(8)) { ref_moe_down(F, 0); } SEAM(8);
    if (IN(9)) { p_ln_ffn(F, 0, WSP(float, WS_H1), WSP(float, WS_H2), WSP(bf16, WS_HB)); } SEAM(9);
    if (IN(10)) {
        bf16* q = WSP(bf16, WS_Q);
        ref_gemm(F, WSP(bf16, WS_HB), DM, WSP(bf16, WS_QKVWT), DM, MTOK, 3 * DM, DM, [=](int m, int n, float v0, float v1) { *(unsigned*)(q + (size_t)(n >> 10) * ((WS_K - WS_Q) / 2) + (size_t)m * DM + (n & 1023)) = pk2(v0, v1); });
    } SEAM(10);
    if (IN(11)) { ref_attention(F); } SEAM(11);
    if (IN(12)) { p_attn_rescale(F); } SEAM(12);
    if (IN(13)) {
        float* pre = WSP(float, WS_PRE2); const float* h2 = WSP(float, WS_H2);
        ref_gemm(F, WSP(bf16, WS_O), DM, WSP(bf16, WS_OWT), DM, MTOK, DM, DM, [=](int m, int n, float v0, float v1) { const size_t o = (size_t)m * DM + n; pre[o] = DN_ALPHA * h2[o] + v0; pre[o + 1] = DN_ALPHA * h2[o + 1] + v1; });
    } SEAM(13);
    if (IN(14)) { p_ln_router(F, 1, WSP(float, WS_PRE2), WSP(float, WS_H1), WSP(bf16, WS_HB)); } SEAM(14);
    if (IN(15)) { ref_moe_gateup(F, 1); } SEAM(15);
    if (IN(16)) { ref_moe_down(F, 1); } SEAM(16);
    if (IN(17)) { p_ln_ffn(F, 1, WSP(float, WS_H1), F.out, nullptr); }
#undef IN
#undef SEAM
}

extern "C" void kernel_launch(void* const* d_in, const int* in_sizes, int n_in, void* d_out, int out_size, void* d_ws, size_t ws_size, hipStream_t stream) {
    static int grid = 0;
    if (grid == 0) {
        if (n_in != 22 || out_size != MTOK * DM || ws_size < WS_END) { fprintf(stderr, "kernel_launch: unexpected shapes (n_in %d out %d ws %zu)\n", n_in, out_size, ws_size); grid = -1; return; }
        int dev = 0, cus = 0, per_cu = 0;
        (void)hipGetDevice(&dev); (void)hipDeviceGetAttribute(&cus, hipDeviceAttributeMultiprocessorCount, dev);
        if (hipFuncSetAttribute((const void*)mk_fwd, hipFuncAttributeMaxDynamicSharedMemorySize, LDS_BYTES) != hipSuccess) { fprintf(stderr, "kernel_launch: hipFuncSetAttribute failed\n"); grid = -1; return; }
        (void)hipOccupancyMaxActiveBlocksPerMultiprocessor(&per_cu, (const void*)mk_fwd, 512, LDS_BYTES);
        (void)hipGetLastError();
        if (per_cu < 1) fprintf(stderr, "kernel_launch: occupancy query says %d\n", per_cu);
        grid = cus;
    }
    if (grid < 0) return;
    (void)hipMemsetAsync((char*)d_ws + WS_CTL, 0, CTL_ZERO_BYTES, stream);
    Args a{};
    for (int i = 0; i < 22; ++i) a.in[i] = (const float*)d_in[i];
    a.out = (float*)d_out; a.ws = (unsigned char*)d_ws;
#ifndef MK_PER_PHASE
#define MK_PER_PHASE 0
#endif
    if (MK_PER_PHASE) {
        for (int p = 0; p < NPH; ++p) { a.ph_lo = p; a.ph_hi = p + 1; hipLaunchKernelGGL(mk_fwd, dim3(grid), dim3(512), LDS_BYTES, stream, a); }
    } else {
        a.ph_lo = 0; a.ph_hi = NPH; hipLaunchKernelGGL(mk_fwd, dim3(grid), dim3(512), LDS_BYTES, stream, a);
    }
}
```

```cpp
#include <hip/hip_runtime.h>
#include <cstdio>
#include <cstdint>

constexpr int BATCH = 8, SEQ = 2048, DM = 1024, MTOK = BATCH * SEQ;
constexpr int DIN = 2048, NH = 32, HD = 64, NGRP = 4, NST = 128, CHK = 128, NCHK = SEQ / CHK, CONVD = 3072, INDIM = 5152, LDZ = 5376;
constexpr int ZX_X = 2048, ZX_B = 4096, ZX_C = 4608, ZX_DT = 5120;
constexpr int AH = 16, AD = 64;
constexpr int NEXP = 32, FF = 512, LISTCAP = MTOK;
constexpr float DN_ALPHA = 1.41421356237309515f, LN_EPS = 1e-5f;
constexpr int NPH = 18;
#ifndef FAST_MASK
#define FAST_MASK 0x1ADB6u
#endif
#define FASTP(k) ((FAST_MASK >> (k)) & 1u)

constexpr size_t MiB = 1u << 20;
constexpr size_t WS_CTL = 0, CTL_ZERO_BYTES = 1 * MiB;
constexpr size_t WS_LIST = 1 * MiB, WS_GLIST = 3 * MiB;
constexpr size_t WS_CD = 5 * MiB;
constexpr size_t WS_RW = 5 * MiB + 65536;
constexpr size_t WS_LSE = 6 * MiB;
constexpr size_t WS_INWT = 8 * MiB, WS_OUTWT = 19 * MiB, WS_QKVWT = 23 * MiB, WS_OWT = 29 * MiB;
constexpr size_t WS_GU0 = 32 * MiB, WS_DN0 = 96 * MiB, WS_GU1 = 128 * MiB, WS_DN1 = 192 * MiB;
constexpr size_t WS_XB = 224 * MiB, WS_ZX = 256 * MiB, WS_ST = 424 * MiB;
constexpr size_t WS_PRE1 = 224 * MiB, WS_H1 = 288 * MiB, WS_HB = 352 * MiB, WS_HID = 384 * MiB, WS_OUT2 = 424 * MiB;
constexpr size_t WS_H2 = 224 * MiB, WS_Q = 384 * MiB, WS_K = 416 * MiB, WS_V = 448 * MiB, WS_O = 480 * MiB, WS_PRE2 = 288 * MiB;
constexpr size_t WS_END = 512 * MiB;
constexpr int CW_BAR = 4096;
constexpr int CW_CNT = 16384;

constexpr int LDS_BYTES = 159744;
constexpr int MISC_OFF = 155648;

#define GAS __attribute__((address_space(1)))
#define LAS __attribute__((address_space(3)))
typedef unsigned short bf16;
typedef unsigned v4u __attribute__((ext_vector_type(4)));
typedef unsigned v2u __attribute__((ext_vector_type(2)));
typedef float f32x4 __attribute__((ext_vector_type(4)));
typedef short bf16x8 __attribute__((ext_vector_type(8)));

__device__ __forceinline__ float bf2f(unsigned v) { return __uint_as_float(v << 16); }
__device__ __forceinline__ float bflo(unsigned w) { return __uint_as_float(w << 16); }
__device__ __forceinline__ float bfhi(unsigned w) { return __uint_as_float(w & 0xffff0000u); }
__device__ __forceinline__ unsigned f2bf(float f) { unsigned u = __float_as_uint(f); return (u + 0x7fffu + ((u >> 16) & 1u)) >> 16; }
__device__ __forceinline__ unsigned pk2(float lo, float hi) { return f2bf(lo) | (f2bf(hi) << 16); }
__device__ __forceinline__ float silu_f(float x) { return x / (1.0f + __expf(-x)); }
__device__ __forceinline__ float softplus_f(float x) { return fmaxf(x, 0.f) + log1pf(__expf(-fabsf(x))); }
__device__ __forceinline__ float wave_sum(float v) {
#pragma unroll
    for (int o = 1; o < 64; o <<= 1) v += __shfl_xor(v, o);
    return v;
}

#define XB_TMO      128
#define XB_XCNT(j)  (256  + 64 * (j))
#define XB_XSUB(j)  (1280 + 64 * (j))
#define XB_XGEN(j)  (2304 + 64 * (j))
#define XB_TOP      3328
#define XB_TOPGEN   3392
#define XCD_BAR_WORDS 3456
#define XB_SPIN_CAP (1u << 22)

__device__ __forceinline__ unsigned xb_ld(unsigned* p)              { return __hip_atomic_load(p, __ATOMIC_RELAXED, __HIP_MEMORY_SCOPE_AGENT); }
__device__ __forceinline__ unsigned xb_add(unsigned* p, unsigned v) { return __hip_atomic_fetch_add(p, v, __ATOMIC_RELAXED, __HIP_MEMORY_SCOPE_AGENT); }
__device__ __forceinline__ unsigned xb_xcc_id() { return (unsigned)__builtin_amdgcn_s_getreg((3 << 11) | 20) & 0xFu; }
#define XB_SPIN(cond, bar) do { unsigned _sp = 0; while (cond) { __builtin_amdgcn_s_sleep(1); \
    if ((++_sp & 255u) == 0u) { if (xb_ld(&(bar)[XB_TMO])) break; if (_sp > XB_SPIN_CAP) { atomicAdd(&(bar)[XB_TMO], 1u); break; } } } } while (0)

struct XcdBarrier { unsigned* bar; unsigned x; volatile LAS unsigned* st; };

__device__ __forceinline__ XcdBarrier xcd_barrier_post(unsigned* bar, volatile LAS unsigned* st) {
    XcdBarrier b; b.bar = bar; b.x = xb_xcc_id(); b.st = st;
    if (threadIdx.x == 0) (void)xb_add(&bar[XB_XCNT(b.x)], 1u);
    return b;
}
__device__ __forceinline__ void xcd_barrier_complete(unsigned* bar, unsigned x, unsigned& nloc, unsigned& nx) {
    const unsigned G = gridDim.x * gridDim.y * gridDim.z;
    unsigned sum, cnt, mine, sp = 0u;
    for (;;) {
        sum = 0u; cnt = 0u; mine = 0u;
#pragma unroll
        for (unsigned j = 0; j < 16; ++j) { const unsigned c = xb_ld(&bar[XB_XCNT(j)]); sum += c; cnt += (c > 0u) ? 1u : 0u; mine = (j == x) ? c : mine; }
        if (sum == G) break;
        __builtin_amdgcn_s_sleep(1);
        if ((++sp & 255u) == 0u) { if (xb_ld(&bar[XB_TMO])) break; if (sp > XB_SPIN_CAP) { atomicAdd(&bar[XB_TMO], 1u); break; } }
    }
    nloc = mine > 0u ? mine : 1u; nx = cnt > 0u ? cnt : 1u;
}
__device__ __forceinline__ void xcd_barrier(const XcdBarrier& b) {
    asm volatile("s_waitcnt vmcnt(0)" ::: "memory");
    __syncthreads();
    if (threadIdx.x == 0) {
        unsigned* bar = b.bar;
        __builtin_amdgcn_s_waitcnt(0);
        unsigned nloc = b.st[0], nx = b.st[1];
        if (nloc == 0u) { xcd_barrier_complete(bar, b.x, nloc, nx); b.st[0] = nloc; b.st[1] = nx; }
        const unsigned old = xb_add(&bar[XB_XSUB(b.x)], 1u);
        const unsigned gen = old / nloc;
        if (old + 1u == (gen + 1u) * nloc) {
            __builtin_amdgcn_fence(__ATOMIC_RELEASE, "agent");
            asm volatile("s_waitcnt vmcnt(0)" ::: "memory");
            const unsigned og = xb_add(&bar[XB_TOP], 1u);
            const unsigned tg = og / nx;
            if (og + 1u == (tg + 1u) * nx) xb_add(&bar[XB_TOPGEN], 1u);
            else XB_SPIN(xb_ld(&bar[XB_TOPGEN]) == tg, bar);
            __builtin_amdgcn_fence(__ATOMIC_ACQUIRE, "agent");
            xb_add(&bar[XB_XGEN(b.x)], 1u);
            asm volatile("s_waitcnt vmcnt(0)" ::: "memory");
        } else {
            XB_SPIN(xb_ld(&bar[XB_XGEN(b.x)]) == gen, bar);
            __builtin_amdgcn_fence(__ATOMIC_ACQUIRE, "agent");
            asm volatile("s_waitcnt vmcnt(0)" ::: "memory");
        }
    }
    __syncthreads();
}

struct Frame {
    LAS unsigned char* lds;
    int tid, lane, wave, G, bid;
    const float* in[22];
    float* out;
    unsigned char* ws;
    unsigned* ctl;
};
#define WSP(T, off) ((T*)(F.ws + (off)))

__device__ __forceinline__ int t5_bucket(int dist) {
    if (dist < 16) return dist;
    int b = 16;
    b += dist >= 22; b += dist >= 30; b += dist >= 40; b += dist >= 54; b += dist >= 73; b += dist >= 99; b += dist >= 134; b += dist >= 182;
    b += dist >= 246; b += dist >= 332; b += dist >= 450; b += dist >= 609; b += dist >= 825; b += dist >= 1117; b += dist >= 1513;
    return b;
}

__device__ __forceinline__ void p0_transpose_item(const float* W, int N, int k0, int n0, bf16* WT, int ldt, int drow0, LAS float* scr, int lane) {
#pragma unroll 8
    for (int i = 0; i < 32; ++i) { const int kk = 2 * i + (lane >> 5); scr[kk * 33 + (lane & 31)] = W[(size_t)(k0 + kk) * N + n0 + (lane & 31)]; }
    asm volatile("s_waitcnt lgkmcnt(0)" ::: "memory");
    const int c = lane & 7;
#pragma unroll
    for (int j = 0; j < 4; ++j) { const int n = (lane >> 3) + 8 * j; const LAS float* s = scr + (8 * c) * 33 + n;
        v4u o; o.x = pk2(s[0 * 33], s[1 * 33]); o.y = pk2(s[2 * 33], s[3 * 33]); o.z = pk2(s[4 * 33], s[5 * 33]); o.w = pk2(s[6 * 33], s[7 * 33]);
        *(v4u*)(WT + (size_t)(drow0 + n) * ldt + k0 + 8 * c) = o; }
    asm volatile("s_waitcnt lgkmcnt(0)" ::: "memory");
}
__device__ __forceinline__ void p0_prologue(Frame& F) {
    LAS float* scr = (LAS float*)(F.lds + F.wave * 16384);
    const int gw = F.bid * 8 + F.wave, NGW = F.G * 8;
    constexpr int I_IN = 16 * 161, I_OUT = 32 * 32, I_KV = 16 * 64, I_Q = 16 * 32, I_O = 16 * 32, I_MOE = 2 * 32 * 256;
    constexpr int NITEMS = I_IN + I_OUT + I_KV + I_Q + I_O + 3 * I_MOE;
    for (int it = gw; it < NITEMS; it += NGW) {
        int r = it;
        if (r < I_IN) { const int kb = r / 161, nb = r % 161; p0_transpose_item(F.in[1], INDIM, kb * 64, nb * 32, WSP(bf16, WS_INWT), DM, nb * 32, scr, F.lane); continue; } r -= I_IN;
        if (r < I_OUT) { const int kb = r / 32, nb = r % 32; p0_transpose_item(F.in[8], DM, kb * 64, nb * 32, WSP(bf16, WS_OUTWT), DIN, nb * 32, scr, F.lane); continue; } r -= I_OUT;
        if (r < I_KV) { const int kb = r / 64, nb = r % 64; p0_transpose_item(F.in[9], 2048, kb * 64, nb * 32, WSP(bf16, WS_QKVWT), DM, 1024 + nb * 32, scr, F.lane); continue; } r -= I_KV;
        if (r < I_Q) { const int kb = r / 32, nb = r % 32; p0_transpose_item(F.in[10], DM, kb * 64, nb * 32, WSP(bf16, WS_QKVWT), DM, nb * 32, scr, F.lane); continue; } r -= I_Q;
        if (r < I_O) { const int kb = r / 32, nb = r % 32; p0_transpose_item(F.in[11], DM, kb * 64, nb * 32, WSP(bf16, WS_OWT), DM, nb * 32, scr, F.lane); continue; } r -= I_O;
        if (r < 2 * I_MOE) {
            const int isup = r / I_MOE; r -= isup * I_MOE;
            const int le = r / 256, q = r % 256, kb = q / 16, nb = q % 16, l = le / 32, e = le % 32;
            const float* W = F.in[isup ? 18 : 17] + (size_t)le * DM * FF;
            bf16* WT = WSP(bf16, l ? WS_GU1 : WS_GU0) + (size_t)e * 1024 * DM;
            const int n0 = nb * 32, drow0 = (n0 >> 7) * 256 + (n0 & 127) + isup * 128;
            p0_transpose_item(W, FF, kb * 64, n0, WT, DM, drow0, scr, F.lane); continue; }
        r -= 2 * I_MOE;
        { const int le = r / 256, q = r % 256, kb = q / 32, nb = q % 32, l = le / 32, e = le % 32;
          const float* W = F.in[19] + (size_t)le * FF * DM;
          bf16* WT = WSP(bf16, l ? WS_DN1 : WS_DN0) + (size_t)e * DM * FF;
          p0_transpose_item(W, DM, kb * 64, nb * 32, WT, FF, nb * 32, scr, F.lane); }
    }
    const int gt = F.bid * 512 + F.tid, NGT = F.G * 512;
    for (int i = gt; i < MTOK * DM / 8; i += NGT) {
        const f32x4 a = ((const f32x4*)F.in[0])[2 * i], b = ((const f32x4*)F.in[0])[2 * i + 1];
        v4u o; o.x = pk2(a.x, a.y); o.y = pk2(a.z, a.w); o.z = pk2(b.x, b.y); o.w = pk2(b.z, b.w);
        WSP(v4u, WS_XB)[i] = o;
    }
    for (int i = gt; i < (LDZ - INDIM) * DM / 8; i += NGT) (WSP(v4u, WS_INWT) + (size_t)INDIM * DM / 8)[i] = (v4u){0u, 0u, 0u, 0u};
}

__device__ __forceinline__ void dot4x2(const bf16* a0, const bf16* a1, const bf16* a2, const bf16* a3, const bf16* b0, const bf16* b1, int K, float (&acc)[4][2]) {
    for (int k = 0; k < K; k += 8) {
        const v4u A0 = *(const v4u*)(a0 + k), A1 = *(const v4u*)(a1 + k), A2 = *(const v4u*)(a2 + k), A3 = *(const v4u*)(a3 + k);
        const v4u B0 = *(const v4u*)(b0 + k), B1 = *(const v4u*)(b1 + k);
#pragma unroll
        for (int j = 0; j < 4; ++j) {
            const float b0l = bflo(B0[j]), b0h = bfhi(B0[j]), b1l = bflo(B1[j]), b1h = bfhi(B1[j]);
            acc[0][0] += bflo(A0[j]) * b0l + bfhi(A0[j]) * b0h; acc[0][1] += bflo(A0[j]) * b1l + bfhi(A0[j]) * b1h;
            acc[1][0] += bflo(A1[j]) * b0l + bfhi(A1[j]) * b0h; acc[1][1] += bflo(A1[j]) * b1l + bfhi(A1[j]) * b1h;
            acc[2][0] += bflo(A2[j]) * b0l + bfhi(A2[j]) * b0h; acc[2][1] += bflo(A2[j]) * b1l + bfhi(A2[j]) * b1h;
            acc[3][0] += bflo(A3[j]) * b0l + bfhi(A3[j]) * b0h; acc[3][1] += bflo(A3[j]) * b1l + bfhi(A3[j]) * b1h;
        }
    }
}
template <class Epi>
__device__ __forceinline__ void ref_gemm(Frame& F, const bf16* A, int lda, const bf16* Bt, int ldb, int M, int N, int K, const Epi& epi) {
    const int tx = F.tid & 63, ty = F.tid >> 6, ntn = N / 128, ntiles = (M / 32) * ntn;
    for (int t = F.bid; t < ntiles; t += F.G) {
        const int m0 = (t / ntn) * 32 + ty * 4, n0 = (t % ntn) * 128 + tx * 2;
        float acc[4][2] = {};
        const bf16* ap = A + (size_t)m0 * lda; const bf16* bp = Bt + (size_t)n0 * ldb;
        dot4x2(ap, ap + lda, ap + 2 * lda, ap + 3 * lda, bp, bp + ldb, K, acc);
#pragma unroll
        for (int r = 0; r < 4; ++r) epi(m0 + r, n0, acc[r][0], acc[r][1]);
    }
}

template <int MODE>
__device__ __forceinline__ void ref_ssd_chunk(Frame& F, int unit) {
    const int b = unit / (NCHK * NGRP), c = (unit / NGRP) % NCHK, g = unit % NGRP;
    const int hl = F.tid >> 6, p = F.tid & 63, h = g * 8 + hl, xch = h * 64 + p;
    const bf16* zx = WSP(bf16, WS_ZX);
    const float* cw = F.in[2]; const float* cbias = F.in[3];
    LAS float* bcL = (LAS float*)F.lds;
    LAS float* red = (LAS float*)(F.lds + 1024);
    float st[NST];
    const size_t sbase = ((size_t)((b * NCHK + c) * NH + h) * HD + p) * NST;
    bf16* stg = WSP(bf16, WS_ST);
    if (MODE == 1) {
#pragma unroll
        for (int n = 0; n < NST; n += 8) { const v4u v = *(const v4u*)(stg + sbase + n);
#pragma unroll
            for (int j = 0; j < 4; ++j) { st[n + 2 * j] = bflo(v[j]); st[n + 2 * j + 1] = bfhi(v[j]); } }
    } else {
#pragma unroll
        for (int n = 0; n < NST; ++n) st[n] = 0.f;
    }
    const int xcol = ZX_X + xch;
    const float xw0 = cw[0 * CONVD + xch], xw1 = cw[1 * CONVD + xch], xw2 = cw[2 * CONVD + xch], xw3 = cw[3 * CONVD + xch], xb_ = cbias[xch];
    const int bcch = (F.tid < 128) ? (2048 + g * 128 + F.tid) : (2048 + 512 + g * 128 + (F.tid - 128));
    const int bccol = ZX_X + bcch;
    float bw0 = 0, bw1 = 0, bw2 = 0, bw3 = 0, bb_ = 0;
    if (F.tid < 256) { bw0 = cw[0 * CONVD + bcch]; bw1 = cw[1 * CONVD + bcch]; bw2 = cw[2 * CONVD + bcch]; bw3 = cw[3 * CONVD + bcch]; bb_ = cbias[bcch]; }
    const float dtb = F.in[4][h], Acoef = -__expf(F.in[5][h]), Dh = F.in[6][h], nw = F.in[7][xch];
    const size_t row0 = (size_t)b * SEQ + (size_t)c * CHK;
    float x1 = 0, x2 = 0, x3 = 0, q1 = 0, q2 = 0, q3 = 0;
    if (c > 0) {
        x1 = bf2f(zx[(row0 - 1) * LDZ + xcol]); x2 = bf2f(zx[(row0 - 2) * LDZ + xcol]); x3 = bf2f(zx[(row0 - 3) * LDZ + xcol]);
        if (F.tid < 256) { q1 = bf2f(zx[(row0 - 1) * LDZ + bccol]); q2 = bf2f(zx[(row0 - 2) * LDZ + bccol]); q3 = bf2f(zx[(row0 - 3) * LDZ + bccol]); }
    }
    float asum = 0.f;
    for (int t = 0; t < CHK; ++t) {
        const size_t row = row0 + t;
        const float x0 = bf2f(zx[row * LDZ + xcol]);
        const float xv = silu_f(xb_ + xw0 * x3 + xw1 * x2 + xw2 * x1 + xw3 * x0);
        x3 = x2; x2 = x1; x1 = x0;
        if (F.tid < 256) { const float q0 = bf2f(zx[row * LDZ + bccol]); bcL[F.tid] = silu_f(bb_ + bw0 * q3 + bw1 * q2 + bw2 * q1 + bw3 * q0); q3 = q2; q2 = q1; q1 = q0; }
        const float dtv = softplus_f(bf2f(zx[row * LDZ + ZX_DT + h]) + dtb);
        const float adt = dtv * Acoef, dA = __expf(adt);
        asum += adt;
        __syncthreads();
        const float xs = dtv * xv;
        float y = 0.f;
#pragma unroll
        for (int n = 0; n < NST; ++n) { st[n] = st[n] * dA + xs * bcL[n]; if (MODE == 1) y += bcL[128 + n] * st[n]; }
        if (MODE == 1) {
            y += Dh * xv;
            y *= silu_f(bf2f(zx[row * LDZ + xch]));
            const float ws2 = wave_sum(y * y);
            if (F.lane == 0) red[hl] = ws2;
            __syncthreads();
            float tot = 0.f;
#pragma unroll
            for (int i = 0; i < 8; ++i) tot += red[i];
            const float rs = 1.0f / sqrtf(tot * (1.0f / 512.0f) + LN_EPS);
            ((bf16*)F.out)[row * DIN + xch] = (bf16)f2bf(y * rs * nw);
        }
        __syncthreads();
    }
    if (MODE == 0) {
#pragma unroll
        for (int n = 0; n < NST; n += 8) { v4u v;
#pragma unroll
            for (int j = 0; j < 4; ++j) v[j] = pk2(st[n + 2 * j], st[n + 2 * j + 1]);
            *(v4u*)(stg + sbase + n) = v; }
        if (p == 0) WSP(float, WS_CD)[(b * NCHK + c) * NH + h] = __expf(asum);
    }
}

__device__ __forceinline__ void p3_scan(Frame& F) {
    bf16* stg = WSP(bf16, WS_ST); const float* cd = WSP(float, WS_CD);
    const int gt = F.bid * 512 + F.tid, NGT = F.G * 512;
    for (int i = gt; i < BATCH * NH * HD * (NST / 8); i += NGT) {
        const int n8 = i & 15, p = (i >> 4) & 63, h = (i >> 10) & 31, b = i >> 15;
        float carry[8] = {0, 0, 0, 0, 0, 0, 0, 0};
        for (int c = 0; c < NCHK; ++c) {
            v4u* ptr = (v4u*)(stg + ((size_t)((b * NCHK + c) * NH + h) * HD + p) * NST + n8 * 8);
            const v4u s = *ptr; const float d = cd[(b * NCHK + c) * NH + h];
            v4u o;
#pragma unroll
            for (int j = 0; j < 4; ++j) { o[j] = pk2(carry[2 * j], carry[2 * j + 1]); carry[2 * j] = carry[2 * j] * d + bflo(s[j]); carry[2 * j + 1] = carry[2 * j + 1] * d + bfhi(s[j]); }
            *ptr = o;
        }
    }
}

__device__ __forceinline__ void ln_row(f32x4 (&v)[4], const float* g, const float* bta, int lane) {
    float s = 0.f;
#pragma unroll
    for (int j = 0; j < 4; ++j) s += (v[j].x + v[j].y) + (v[j].z + v[j].w);
    const float mean = wave_sum(s) * (1.f / DM); float s2 = 0.f;
#pragma unroll
    for (int j = 0; j < 4; ++j) { v[j] = v[j] - mean; s2 += (v[j].x * v[j].x + v[j].y * v[j].y) + (v[j].z * v[j].z + v[j].w * v[j].w); }
    const float rstd = 1.0f / sqrtf(wave_sum(s2) * (1.f / DM) + LN_EPS);
#pragma unroll
    for (int j = 0; j < 4; ++j) { const f32x4 gg = ((const f32x4*)g)[lane + 64 * j], bb = ((const f32x4*)bta)[lane + 64 * j]; v[j] = v[j] * rstd * gg + bb; }
}
__device__ __forceinline__ void store_row_f32_bf16(const f32x4 (&v)[4], float* of, bf16* ob, int lane) {
#pragma unroll
    for (int j = 0; j < 4; ++j) {
        if (of) ((f32x4*)of)[lane + 64 * j] = v[j];
        if (ob) ((v2u*)ob)[lane + 64 * j] = (v2u){pk2(v[j].x, v[j].y), pk2(v[j].z, v[j].w)};
    }
}

__device__ __forceinline__ void p_ln_router(Frame& F, int layer, const float* pre, float* hf, bf16* hb) {
    const float* lg = F.in[20] + (size_t)(layer * 2 + 0) * DM; const float* lb = F.in[21] + (size_t)(layer * 2 + 0) * DM;
    const float* gw = F.in[13] + (size_t)layer * DM * 4; const float* gb = F.in[14] + layer * 4;
    const float* ew = F.in[15] + (size_t)layer * 4 * DM * 8; const float* eb = F.in[16] + layer * 32;
    unsigned* cnt = F.ctl + CW_CNT + layer * 64 * 32;
    int* list = WSP(int, WS_LIST); float* glist = WSP(float, WS_GLIST);
    const int gwv = F.bid * 8 + F.wave, NGW = F.G * 8, lane = F.lane;
    for (int tok = gwv; tok < MTOK; tok += NGW) {
        f32x4 v[4];
#pragma unroll
        for (int j = 0; j < 4; ++j) v[j] = ((const f32x4*)(pre + (size_t)tok * DM))[lane + 64 * j];
        ln_row(v, lg, lb, lane);
        store_row_f32_bf16(v, hf + (size_t)tok * DM, hb + (size_t)tok * DM, lane);
        float gl[4] = {0, 0, 0, 0};
#pragma unroll
        for (int j = 0; j < 4; ++j)
#pragma unroll
            for (int i = 0; i < 4; ++i) { const int k = 4 * lane + 256 * j + i; const f32x4 w = ((const f32x4*)gw)[k]; const float hv = v[j][i];
                gl[0] += hv * w.x; gl[1] += hv * w.y; gl[2] += hv * w.z; gl[3] += hv * w.w; }
#pragma unroll
        for (int q = 0; q < 4; ++q) gl[q] = wave_sum(gl[q]) + gb[q];
        int gi = 0; float gm = gl[0];
#pragma unroll
        for (int q = 1; q < 4; ++q) if (gl[q] > gm) { gm = gl[q]; gi = q; }
        float gden = 0.f;
#pragma unroll
        for (int q = 0; q < 4; ++q) gden += __expf(gl[q] - gm);
        const float gval = 1.0f / gden;
        float el[8] = {0, 0, 0, 0, 0, 0, 0, 0};
        const float* ewg = ew + (size_t)gi * DM * 8;
#pragma unroll
        for (int j = 0; j < 4; ++j)
#pragma unroll
            for (int i = 0; i < 4; ++i) { const int k = 4 * lane + 256 * j + i; const f32x4 w0 = ((const f32x4*)ewg)[2 * k], w1 = ((const f32x4*)ewg)[2 * k + 1]; const float hv = v[j][i];
                el[0] += hv * w0.x; el[1] += hv * w0.y; el[2] += hv * w0.z; el[3] += hv * w0.w; el[4] += hv * w1.x; el[5] += hv * w1.y; el[6] += hv * w1.z; el[7] += hv * w1.w; }
#pragma unroll
        for (int q = 0; q < 8; ++q) el[q] = wave_sum(el[q]) + eb[gi * 8 + q];
        int i1 = 0; float v1 = el[0];
#pragma unroll
        for (int q = 1; q < 8; ++q) if (el[q] > v1) { v1 = el[q]; i1 = q; }
        int i2 = -1; float v2 = -3.0e38f;
#pragma unroll
        for (int q = 0; q < 8; ++q) if (q != i1 && el[q] > v2) { v2 = el[q]; i2 = q; }
        const float e2 = __expf(v2 - v1), p1 = gval / (1.0f + e2), p2 = gval * e2 / (1.0f + e2);
        if (lane == 0) {
            const int ea = gi * 8 + i1, ebx = gi * 8 + i2;
            const unsigned s1 = atomicAdd(cnt + ea * 64, 1u); list[ea * LISTCAP + s1] = tok * 2; glist[ea * LISTCAP + s1] = p1;
            const unsigned s2 = atomicAdd(cnt + ebx * 64, 1u); list[ebx * LISTCAP + s2] = tok * 2 + 1; glist[ebx * LISTCAP + s2] = p2;
        }
    }
}

struct MoeTab { volatile LAS int* ts; volatile LAS int* cn; };
__device__ __forceinline__ MoeTab moe_table(Frame& F, int layer) {
    MoeTab T; T.ts = (volatile LAS int*)(F.lds + MISC_OFF + 256); T.cn = (volatile LAS int*)(F.lds + MISC_OFF + 512);
    __syncthreads();
    if (F.tid == 0) { int acc = 0; for (int e = 0; e < NEXP; ++e) { const int c = (int)__hip_atomic_load(F.ctl + CW_CNT + layer * 64 * 32 + e * 64, __ATOMIC_RELAXED, __HIP_MEMORY_SCOPE_AGENT); T.cn[e] = c; T.ts[e] = acc; acc += (c + 255) >> 8; } T.ts[NEXP] = acc; }
    __syncthreads();
    return T;
}
__device__ __forceinline__ void moe_find(const MoeTab& T, int rt, int& e, int& j) { int ee = 0; while (ee < NEXP - 1 && T.ts[ee + 1] <= rt) ++ee; e = ee; j = rt - T.ts[ee]; }

__device__ __forceinline__ void ref_moe_gateup(Frame& F, int layer) {
    const MoeTab T = moe_table(F, layer);
    const bf16* hb = WSP(bf16, WS_HB); const bf16* gu = WSP(bf16, layer ? WS_GU1 : WS_GU0); bf16* hid = WSP(bf16, WS_HID);
    const int* list = WSP(int, WS_LIST); const float* glist = WSP(float, WS_GLIST);
    const int nunits = T.ts[NEXP] * 4, fl = F.tid & 127, ty = F.tid >> 7;
    for (int u = F.bid; u < nunits; u += F.G) {
        const int rt = u >> 2, pn = u & 3; int e, j; moe_find(T, rt, e, j);
        const int cnt = T.cn[e];
        const bf16* bg = gu + ((size_t)e * 1024 + pn * 256 + fl) * DM; const bf16* bu = bg + (size_t)128 * DM;
        for (int rr = ty * 4; rr < 256; rr += 16) {
            const bf16* ap[4]; float gv[4];
#pragma unroll
            for (int r = 0; r < 4; ++r) { const int slot = j * 256 + rr + r; const bool ok = slot < cnt; const int pair = ok ? list[e * LISTCAP + slot] : 0; gv[r] = ok ? glist[e * LISTCAP + slot] : 0.f; ap[r] = hb + (size_t)(pair >> 1) * DM; }
            float acc[4][2] = {};
            dot4x2(ap[0], ap[1], ap[2], ap[3], bg, bu, DM, acc);
#pragma unroll
            for (int r = 0; r < 4; ++r) hid[((size_t)rt * 256 + rr + r) * FF + pn * 128 + fl] = (bf16)f2bf(silu_f(acc[r][0]) * acc[r][1] * gv[r]);
        }
    }
}
__device__ __forceinline__ void ref_moe_down(Frame& F, int layer) {
    const MoeTab T = moe_table(F, layer);
    const bf16* hid = WSP(bf16, WS_HID); const bf16* dn = WSP(bf16, layer ? WS_DN1 : WS_DN0); bf16* out2 = WSP(bf16, WS_OUT2);
    const int* list = WSP(int, WS_LIST);
    const int nunits = T.ts[NEXP] * 4, tx = F.tid & 127, ty = F.tid >> 7;
    for (int u = F.bid; u < nunits; u += F.G) {
        const int rt = u >> 2, pn = u & 3; int e, j; moe_find(T, rt, e, j);
        const int cnt = T.cn[e];
        const bf16* b0 = dn + ((size_t)e * DM + pn * 256 + tx * 2) * FF; const bf16* b1 = b0 + FF;
        for (int rr = ty * 4; rr < 256; rr += 16) {
            const bf16* a0 = hid + ((size_t)rt * 256 + rr) * FF;
            float acc[4][2] = {};
            dot4x2(a0, a0 + FF, a0 + 2 * FF, a0 + 3 * FF, b0, b1, FF, acc);
#pragma unroll
            for (int r = 0; r < 4; ++r) { const int slot = j * 256 + rr + r; if (slot < cnt) { const int pair = list[e * LISTCAP + slot];
                *(unsigned*)(out2 + (size_t)pair * DM + pn * 256 + tx * 2) = pk2(acc[r][0], acc[r][1]); } }
        }
    }
}
__device__ __forceinline__ void p_ln_ffn(Frame& F, int layer, const float* hf, float* of, bf16* ob) {
    const float* lg = F.in[20] + (size_t)(layer * 2 + 1) * DM; const float* lb = F.in[21] + (size_t)(layer * 2 + 1) * DM;
    const bf16* out2 = WSP(bf16, WS_OUT2);
    const int gwv = F.bid * 8 + F.wave, NGW = F.G * 8, lane = F.lane;
    for (int tok = gwv; tok < MTOK; tok += NGW) {
        f32x4 v[4];
#pragma unroll
        for (int j = 0; j < 4; ++j) {
            const f32x4 hv = ((const f32x4*)(hf + (size_t)tok * DM))[lane + 64 * j];
            const v2u a = ((const v2u*)(out2 + (size_t)(2 * tok) * DM))[lane + 64 * j], b = ((const v2u*)(out2 + (size_t)(2 * tok + 1) * DM))[lane + 64 * j];
            v[j].x = DN_ALPHA * hv.x + (bflo(a.x) + bflo(b.x)); v[j].y = DN_ALPHA * hv.y + (bfhi(a.x) + bfhi(b.x));
            v[j].z = DN_ALPHA * hv.z + (bflo(a.y) + bflo(b.y)); v[j].w = DN_ALPHA * hv.w + (bfhi(a.y) + bfhi(b.y));
        }
        ln_row(v, lg, lb, lane);
        store_row_f32_bf16(v, of + (size_t)tok * DM, ob ? ob + (size_t)tok * DM : nullptr, lane);
    }
}

__device__ __forceinline__ void ref_attention(Frame& F) {
    const bf16* Q = WSP(bf16, WS_Q); const bf16* Kb = WSP(bf16, WS_K); const bf16* Vb = WSP(bf16, WS_V); bf16* O = WSP(bf16, WS_O); float* lse = WSP(float, WS_LSE);
    const float* relb = F.in[12];
    const int gt = F.bid * 512 + F.tid, NGT = F.G * 512;
    for (int i = gt; i < MTOK * AH; i += NGT) {
        const int hd = i & 15, row = i >> 4, t = row & (SEQ - 1), rb = row - t;
        const int dil = hd < 6 ? 1 : (hd < 11 ? 4 : 16);
        float q[AD], o[AD];
#pragma unroll
        for (int d = 0; d < AD; d += 8) { const v4u v = *(const v4u*)(Q + (size_t)row * DM + hd * AD + d);
#pragma unroll
            for (int j = 0; j < 4; ++j) { q[d + 2 * j] = bflo(v[j]); q[d + 2 * j + 1] = bfhi(v[j]); } }
#pragma unroll
        for (int d = 0; d < AD; ++d) o[d] = 0.f;
        float m = -3.0e38f, l = 0.f;
        for (int delta = 0; delta <= 128; ++delta) {
            const int kt = t - delta * dil; if (kt < 0) break;
            const size_t kr = (size_t)(rb + kt) * DM + hd * AD;
            float s = 0.f;
#pragma unroll
            for (int d = 0; d < AD; d += 8) { const v4u v = *(const v4u*)(Kb + kr + d);
#pragma unroll
                for (int j = 0; j < 4; ++j) s += q[d + 2 * j] * bflo(v[j]) + q[d + 2 * j + 1] * bfhi(v[j]); }
            s = s * 0.125f + relb[t5_bucket(delta * dil) * AH + hd];
            const float mn = fmaxf(m, s), sc = __expf(m - mn), pw = __expf(s - mn);
            l = l * sc + pw; m = mn;
#pragma unroll
            for (int d = 0; d < AD; d += 8) { const v4u v = *(const v4u*)(Vb + kr + d);
#pragma unroll
                for (int j = 0; j < 4; ++j) { o[d + 2 * j] = o[d + 2 * j] * sc + pw * bflo(v[j]); o[d + 2 * j + 1] = o[d + 2 * j + 1] * sc + pw * bfhi(v[j]); } }
        }
        const float inv = 1.0f / l;
#pragma unroll
        for (int d = 0; d < AD; d += 8) { v4u v;
#pragma unroll
            for (int j = 0; j < 4; ++j) v[j] = pk2(o[d + 2 * j] * inv, o[d + 2 * j + 1] * inv);
            *(v4u*)(O + (size_t)row * DM + hd * AD + d) = v; }
        lse[(size_t)row * AH + hd] = m + __logf(l);
    }
}
__device__ __forceinline__ void p_attn_rescale(Frame& F) {
    bf16* O = WSP(bf16, WS_O); const float* lse = WSP(float, WS_LSE);
    const int gwv = F.bid * 8 + F.wave, NGW = F.G * 8, lane = F.lane;
    for (int row = gwv; row < MTOK; row += NGW) {
        const float lv = lane < 16 ? lse[(size_t)row * AH + lane] : 0.f;
        float s0 = 0.f, s1 = 0.f, s2 = 0.f;
#pragma unroll
        for (int hh = 0; hh < 16; ++hh) { const float x = __shfl(lv, hh); if (hh < 6) s0 += x; else if (hh < 11) s1 += x; else s2 += x; }
        s0 *= (1.f / 6.f); s1 *= 0.2f; s2 *= 0.2f;
        const float mx = fmaxf(s0, fmaxf(s1, s2)), e0 = __expf(s0 - mx), e1 = __expf(s1 - mx), e2 = __expf(s2 - mx), inv = 3.0f / (e0 + e1 + e2);
        const int hd = lane >> 2; const float w = (hd < 6 ? e0 : (hd < 11 ? e1 : e2)) * inv;
        v4u* p = (v4u*)(O + (size_t)row * DM + lane * 16);
#pragma unroll
        for (int c = 0; c < 2; ++c) { v4u v = p[c];
#pragma unroll
            for (int j = 0; j < 4; ++j) v[j] = pk2(bflo(v[j]) * w, bfhi(v[j]) * w);
            p[c] = v; }
    }
}

namespace pg8 {
constexpr int BM = 256, BK = 64, HALF = 128, HTB = HALF * BK * 2, STAGE_BYTES = 8 * HTB, NXCD = 8, WGM = 8;
__host__ __device__ __forceinline__ int lds_byte(int r, int c) { const int st = (r >> 4) * 2 + (c >> 5), rr = r & 15, cc = c & 31, ob = rr * 64 + cc * 2; return st * 1024 + (ob ^ (((ob >> 9) & 1) << 5)); }
__host__ __device__ __forceinline__ void stage_rc(int b, int& R, int& C) { const int st = b / 1024, sb = b % 1024, swz = sb ^ (((sb >> 9) & 1) << 5); R = (st >> 1) * 16 + swz / 64; C = (st & 1) * 32 + (swz % 64) / 2; }
__host__ __device__ __forceinline__ int perm32(int rho) { const int n = rho >> 4, i = rho & 15; return 8 * (i >> 2) + 4 * n + (i & 3); }
__device__ __forceinline__ unsigned cvt_pk_bf16(float lo, float hi) { unsigned r; asm volatile("v_cvt_pk_bf16_f32 %0, %1, %2" : "=v"(r) : "v"(lo), "v"(hi)); return r; }

struct Unit { int pm, pn, e, j; };

struct DenseSched {
    static constexpr bool GATHER = false;
    const bf16* A; const bf16* Bt; int K, nM, nN, nwg, G, c;
    __device__ __forceinline__ void init(const bf16* A_, const bf16* Bt_, int M, int N, int K_, int G_, int c_) { A = A_; Bt = Bt_; K = K_; nM = M / BM; nN = N / BM; nwg = nM * nN; G = G_; c = c_; }
    __device__ __forceinline__ bool next(int i, Unit& u) const {
        const long L = (long)i * G + c; if (L >= nwg) return false;
        int wgid = (int)L; { const int q = nwg / NXCD, r = nwg % NXCD, xcd = wgid % NXCD, off = wgid / NXCD; wgid = (xcd < r ? xcd * (q + 1) : r * (q + 1) + (xcd - r) * q) + off; }
        const int nig = WGM * nN, gid = wgid / nig, fm = gid * WGM, gsz = (nM - fm) < WGM ? (nM - fm) : WGM;
        u.pm = fm + ((wgid % nig) % gsz); u.pn = (wgid % nig) / gsz; u.e = 0; u.j = 0; return true;
    }
    __device__ __forceinline__ const char* a_base(const Unit& u) const { return (const char*)A + (size_t)u.pm * BM * K * 2; }
    __device__ __forceinline__ const char* b_base(const Unit& u) const { return (const char*)Bt + (size_t)u.pn * BM * K * 2; }
    __device__ __forceinline__ void a_voff(const Unit&, unsigned (&)[2][2]) const {}
};
struct MoeGuSched {
    static constexpr bool GATHER = true;
    const bf16* A; const bf16* Bt; const int* list; MoeTab T; int K, G, c, nunits;
    __device__ __forceinline__ bool next(int i, Unit& u) const { const int L = i * G + c; if (L >= nunits) return false; u.pm = L >> 2; u.pn = L & 3; moe_find(T, u.pm, u.e, u.j); return true; }
    __device__ __forceinline__ const char* a_base(const Unit&) const { return (const char*)A; }
    __device__ __forceinline__ const char* b_base(const Unit& u) const { return (const char*)Bt + ((size_t)u.e * 1024 + u.pn * 256) * K * 2; }
    __device__ __forceinline__ void a_voff(const Unit& u, unsigned (&vo)[2][2]) const {
        const int cnt = T.cn[u.e];
        int tz = threadIdx.x; asm volatile("" : "+v"(tz));
#pragma unroll
        for (int i = 0; i < 2; ++i) { int R, C; stage_rc(tz * 16 + i * 8192, R, C);
#pragma unroll
            for (int h = 0; h < 2; ++h) { const int slot = u.j * 256 + h * 128 + R; const int pair = slot < cnt ? list[u.e * LISTCAP + slot] : 0; vo[h][i] = (unsigned)((pair >> 1) * K + C) * 2u; } }
    }
};
struct MoeDnSched {
    static constexpr bool GATHER = false;
    const bf16* A; const bf16* Bt; MoeTab T; int K, G, c, nunits;
    __device__ __forceinline__ bool next(int i, Unit& u) const { const int L = i * G + c; if (L >= nunits) return false; u.pm = L >> 2; u.pn = L & 3; moe_find(T, u.pm, u.e, u.j); return true; }
    __device__ __forceinline__ const char* a_base(const Unit& u) const { return (const char*)A + (size_t)u.pm * BM * K * 2; }
    __device__ __forceinline__ const char* b_base(const Unit& u) const { return (const char*)Bt + ((size_t)u.e * 1024 + u.pn * 256) * K * 2; }
    __device__ __forceinline__ void a_voff(const Unit&, unsigned (&)[2][2]) const {}
};

struct EpiBf16 {
    static constexpr bool PERM = true;
    bf16* O; int ldc; int split_cols; size_t split_stride;
    __device__ __forceinline__ void operator()(const f32x4 (&acc)[2][2][4][2], const Unit& u, int wr, int wc, int fr, int fq) const {
        const int row0 = u.pm * BM + wr * 64 + fr; int colt = u.pn * BM; bf16* base = O;
        if (split_cols) { const int t = colt / split_cols; base += (size_t)t * split_stride; colt -= t * split_cols; }
        const int col0 = colt + wc * 32 + 8 * fq;
#pragma unroll
        for (int ai = 0; ai < 2; ++ai)
#pragma unroll
            for (int m = 0; m < 4; ++m) { bf16* rowp = base + (size_t)(row0 + ai * HALF + m * 16) * ldc + col0;
#pragma unroll
                for (int bj = 0; bj < 2; ++bj) { const f32x4 v0 = acc[ai][bj][m][0], v1 = acc[ai][bj][m][1];
                    v4u w; w.x = cvt_pk_bf16(v0[0], v0[1]); w.y = cvt_pk_bf16(v0[2], v0[3]); w.z = cvt_pk_bf16(v1[0], v1[1]); w.w = cvt_pk_bf16(v1[2], v1[3]);
                    *(v4u*)(rowp + bj * HALF) = w; } }
    }
};
struct EpiResF32 {
    static constexpr bool PERM = false;
    float* C; const float* res; int ldc;
    __device__ __forceinline__ void operator()(const f32x4 (&acc)[2][2][4][2], const Unit& u, int wr, int wc, int fr, int fq) const {
        const int row0 = u.pm * BM + wr * 64 + fr, col0 = u.pn * BM + wc * 32 + 4 * fq;
#pragma unroll
        for (int ai = 0; ai < 2; ++ai)
#pragma unroll
            for (int m = 0; m < 4; ++m) { const size_t ro = (size_t)(row0 + ai * HALF + m * 16) * ldc + col0;
#pragma unroll
                for (int bj = 0; bj < 2; ++bj)
#pragma unroll
                    for (int n = 0; n < 2; ++n) { const f32x4 rv = *(const f32x4*)(res + ro + bj * HALF + n * 16); *(f32x4*)(C + ro + bj * HALF + n * 16) = rv * DN_ALPHA + acc[ai][bj][m][n]; } }
    }
};
struct EpiGateUp {
    static constexpr bool PERM = true;
    bf16* hid; const float* glist; MoeTab T;
    __device__ __forceinline__ void operator()(const f32x4 (&acc)[2][2][4][2], const Unit& u, int wr, int wc, int fr, int fq) const {
        const int cnt = T.cn[u.e];
#pragma unroll
        for (int ai = 0; ai < 2; ++ai)
#pragma unroll
            for (int m = 0; m < 4; ++m) { const int r = ai * HALF + wr * 64 + m * 16 + fr, slot = u.j * 256 + r;
                const float gv = slot < cnt ? glist[u.e * LISTCAP + slot] : 0.f;
                float o[8];
#pragma unroll
                for (int n = 0; n < 2; ++n)
#pragma unroll
                    for (int q = 0; q < 4; ++q) { const float g = acc[ai][0][m][n][q], up = acc[ai][1][m][n][q]; o[n * 4 + q] = g / (1.0f + __expf(-g)) * up * gv; }
                v4u w; w.x = cvt_pk_bf16(o[0], o[1]); w.y = cvt_pk_bf16(o[2], o[3]); w.z = cvt_pk_bf16(o[4], o[5]); w.w = cvt_pk_bf16(o[6], o[7]);
                *(v4u*)(hid + ((size_t)u.pm * 256 + r) * FF + u.pn * 128 + wc * 32 + 8 * fq) = w; }
    }
};
struct EpiDown {
    static constexpr bool PERM = true;
    bf16* out2; const int* list; MoeTab T;
    __device__ __forceinline__ void operator()(const f32x4 (&acc)[2][2][4][2], const Unit& u, int wr, int wc, int fr, int fq) const {
        const int cnt = T.cn[u.e];
#pragma unroll
        for (int ai = 0; ai < 2; ++ai)
#pragma unroll
            for (int m = 0; m < 4; ++m) { const int r = ai * HALF + wr * 64 + m * 16 + fr, slot = u.j * 256 + r;
                if (slot < cnt) { const int pair = list[u.e * LISTCAP + slot]; bf16* rowp = out2 + (size_t)pair * DM + u.pn * 256 + wc * 32 + 8 * fq;
#pragma unroll
                    for (int bj = 0; bj < 2; ++bj) { const f32x4 v0 = acc[ai][bj][m][0], v1 = acc[ai][bj][m][1];
                        v4u w; w.x = cvt_pk_bf16(v0[0], v0[1]); w.y = cvt_pk_bf16(v0[2], v0[3]); w.z = cvt_pk_bf16(v1[0], v1[1]); w.w = cvt_pk_bf16(v1[2], v1[3]);
                        *(v4u*)(rowp + bj * HALF) = w; } } }
    }
};

template <class Epi, class Sched, bool ALIGN_EPI, bool SP2>
__device__ __forceinline__ void gemm_phase(LAS unsigned char* lds, const Sched& S, const Epi& E) {
    constexpr bool GATHER = Sched::GATHER;
    const int tid = threadIdx.x, wid = __builtin_amdgcn_readfirstlane(tid >> 6), lane = tid & 63, wr = wid >> 2, wc = wid & 3, fr = lane & 15, fq = lane >> 4;
    const int K = S.K, nt = K / BK;
    unsigned voffA[2], voffB[2];
#pragma unroll
    for (int i = 0; i < 2; ++i) { int R, C; stage_rc(tid * 16 + i * 8192, R, C); const int Rb = Epi::PERM ? ((R & ~31) + perm32(R & 31)) : R;
        voffA[i] = (unsigned)(R * K + C) * 2u; voffB[i] = (unsigned)(Rb * K + C) * 2u; }
    const size_t kstep = (size_t)(BK * 2);
    const size_t hstep = (size_t)HALF * K * 2;
    const size_t hstepA = GATHER ? 0 : hstep;
    const unsigned ldsw = (unsigned)wid * 1024u;
    const int aoff = lds_byte(wr * 64 + fr, fq * 8), boff = lds_byte(wc * 32 + fr, fq * 8);
#define PG8_SA(b, h) (((b) * 2 + (h)) * HTB)
#define PG8_SB(b, h) ((4 + (b) * 2 + (h)) * HTB)
#define PG8_STAGE2(bufoff, gbase, o0, o1) do { \
        __builtin_amdgcn_global_load_lds((const unsigned*)((const char*)(gbase) + (o0)), (LAS unsigned*)(lds + (bufoff) + ldsw), 16, 0, 0); \
        __builtin_amdgcn_global_load_lds((const unsigned*)((const char*)(gbase) + (o1)), (LAS unsigned*)(lds + (bufoff) + ldsw + 8192), 16, 0, 0); } while (0)
#define PG8_STAGEB(bufoff, gbase) PG8_STAGE2(bufoff, gbase, voffB[0], voffB[1])
#define PG8_LDA(dst, b, h) do { _Pragma("unroll") for (int m = 0; m < 4; ++m) _Pragma("unroll") for (int k = 0; k < 2; ++k) dst[m][k] = *(const LAS bf16x8*)(lds + PG8_SA(b, h) + aoff + m * 2048 + k * 1024); } while (0)
#define PG8_LDB(dst, b, h) do { _Pragma("unroll") for (int n = 0; n < 2; ++n) _Pragma("unroll") for (int k = 0; k < 2; ++k) dst[n][k] = *(const LAS bf16x8*)(lds + PG8_SB(b, h) + boff + n * 2048 + k * 1024); } while (0)
#define PG8_MMA(ai, bj, At, Bt) do { __builtin_amdgcn_s_setprio(1); _Pragma("unroll") for (int m = 0; m < 4; ++m) _Pragma("unroll") for (int n = 0; n < 2; ++n) _Pragma("unroll") for (int k = 0; k < 2; ++k) \
        acc[ai][bj][m][n] = __builtin_amdgcn_mfma_f32_16x16x32_bf16(Bt[n][k], At[m][k], acc[ai][bj][m][n], 0, 0, 0); __builtin_amdgcn_s_setprio(0); } while (0)
#define PG8_WAIT_V(n) asm volatile("s_waitcnt vmcnt(" #n ")" ::: "memory")
#define PG8_WAIT_L(n) asm volatile("s_waitcnt lgkmcnt(" #n ")" ::: "memory")
#define PG8_BAR __builtin_amdgcn_s_barrier()
#define PG8_SCHED __builtin_amdgcn_sched_barrier(0)
    Unit cur, nxt; int ui = 0;
    if (!S.next(0, cur)) return;
    f32x4 acc[2][2][4][2];
#pragma unroll
    for (int a = 0; a < 2; ++a)
#pragma unroll
        for (int b = 0; b < 2; ++b)
#pragma unroll
            for (int m = 0; m < 4; ++m)
#pragma unroll
                for (int n = 0; n < 2; ++n) acc[a][b][m][n] = (f32x4){0.f, 0.f, 0.f, 0.f};
    bf16x8 At[4][2], B0[2][2], B1[2][2];
    unsigned cvo[2][2];
    if constexpr (GATHER) S.a_voff(cur, cvo); else { cvo[0][0] = cvo[1][0] = voffA[0]; cvo[0][1] = cvo[1][1] = voffA[1]; }
    const char* cA = S.a_base(cur); const char* cB = S.b_base(cur);
    if constexpr (SP2) {
        PG8_STAGEB(PG8_SB(0, 0), cB); PG8_STAGEB(PG8_SB(0, 1), cB + hstep); PG8_STAGE2(PG8_SA(0, 0), cA, cvo[0][0], cvo[0][1]); PG8_STAGE2(PG8_SA(0, 1), cA + hstepA, cvo[1][0], cvo[1][1]);
        if (wr == 1) PG8_BAR;
        PG8_WAIT_V(2); PG8_BAR;
        PG8_STAGEB(PG8_SB(1, 0), cB + kstep); PG8_STAGE2(PG8_SA(1, 0), cA + kstep, cvo[0][0], cvo[0][1]); PG8_STAGEB(PG8_SB(1, 1), cB + hstep + kstep);
        PG8_WAIT_V(6); PG8_BAR;
    } else {
        PG8_STAGEB(PG8_SB(0, 0), cB); PG8_STAGE2(PG8_SA(0, 0), cA, cvo[0][0], cvo[0][1]); PG8_STAGEB(PG8_SB(0, 1), cB + hstep); PG8_STAGE2(PG8_SA(0, 1), cA + hstepA, cvo[1][0], cvo[1][1]);
        if (wr == 1) PG8_BAR;
        PG8_WAIT_V(4); PG8_BAR;
        PG8_STAGEB(PG8_SB(1, 0), cB + kstep); PG8_STAGE2(PG8_SA(1, 0), cA + kstep, cvo[0][0], cvo[0][1]); PG8_STAGEB(PG8_SB(1, 1), cB + hstep + kstep);
        PG8_WAIT_V(6); PG8_BAR;
    }
    for (;;) {
        const bool has_next = S.next(ui + 1, nxt);
        const char* nA = has_next ? S.a_base(nxt) : cA; const char* nB = has_next ? S.b_base(nxt) : cB;
        for (int t = 0; t < nt; t += 2) {
            const bool last = (t == nt - 2);
            const char* a1 = cA + (size_t)(t + 1) * kstep;
            const char* a2 = last ? nA : cA + (size_t)(t + 2) * kstep; const char* b2 = last ? nB : cB + (size_t)(t + 2) * kstep;
            const char* a3 = a2 + kstep; const char* b3 = b2 + kstep;
            if constexpr (SP2) {
            PG8_LDB(B0, 0, 0); PG8_LDB(B1, 0, 1); PG8_SCHED; PG8_LDA(At, 0, 0); PG8_STAGE2(PG8_SA(1, 1), a1 + hstepA, cvo[1][0], cvo[1][1]);
            if constexpr (GATHER) { if (last && has_next) S.a_voff(nxt, cvo); }
            PG8_WAIT_V(8); PG8_WAIT_L(0); PG8_BAR; PG8_MMA(0, 0, At, B0); PG8_MMA(0, 1, At, B1); PG8_BAR; PG8_SCHED;
            PG8_LDA(At, 0, 1); PG8_STAGEB(PG8_SB(0, 0), b2); PG8_STAGEB(PG8_SB(0, 1), b2 + hstep); PG8_STAGE2(PG8_SA(0, 0), a2, cvo[0][0], cvo[0][1]);
            PG8_WAIT_V(8); PG8_WAIT_L(0); PG8_BAR; PG8_MMA(1, 0, At, B0); PG8_MMA(1, 1, At, B1); PG8_BAR; PG8_SCHED;
            PG8_LDB(B0, 1, 0); PG8_LDB(B1, 1, 1); PG8_SCHED; PG8_LDA(At, 1, 0); PG8_STAGE2(PG8_SA(0, 1), a2 + hstepA, cvo[1][0], cvo[1][1]);
            PG8_WAIT_V(8); PG8_WAIT_L(0); PG8_BAR; PG8_MMA(0, 0, At, B0); PG8_MMA(0, 1, At, B1); PG8_BAR; PG8_SCHED;
            PG8_LDA(At, 1, 1); PG8_STAGEB(PG8_SB(1, 0), b3); PG8_STAGEB(PG8_SB(1, 1), b3 + hstep); PG8_STAGE2(PG8_SA(1, 0), a3, cvo[0][0], cvo[0][1]);
            PG8_WAIT_V(8); PG8_WAIT_L(0); PG8_BAR; PG8_MMA(1, 0, At, B0); PG8_MMA(1, 1, At, B1); PG8_BAR; PG8_SCHED;
            } else {
            PG8_LDB(B0, 0, 0); PG8_SCHED; PG8_LDA(At, 0, 0); PG8_STAGE2(PG8_SA(1, 1), a1 + hstepA, cvo[1][0], cvo[1][1]);
            if constexpr (GATHER) { if (last && has_next) S.a_voff(nxt, cvo); }
            PG8_WAIT_L(8); PG8_BAR; PG8_WAIT_L(0); PG8_MMA(0, 0, At, B0); PG8_BAR; PG8_SCHED;
            PG8_LDB(B1, 0, 1); PG8_STAGEB(PG8_SB(0, 0), b2);
            PG8_BAR; PG8_WAIT_L(0); PG8_MMA(0, 1, At, B1); PG8_BAR;
            PG8_LDA(At, 0, 1); PG8_STAGE2(PG8_SA(0, 0), a2, cvo[0][0], cvo[0][1]);
            PG8_BAR; PG8_WAIT_L(0); PG8_MMA(1, 0, At, B0); PG8_BAR; PG8_SCHED;
            PG8_STAGEB(PG8_SB(0, 1), b2 + hstep);
            PG8_WAIT_V(6); PG8_BAR; PG8_MMA(1, 1, At, B1); PG8_BAR;
            PG8_LDB(B0, 1, 0); PG8_SCHED; PG8_LDA(At, 1, 0); PG8_STAGE2(PG8_SA(0, 1), a2 + hstepA, cvo[1][0], cvo[1][1]);
            PG8_WAIT_L(8); PG8_BAR; PG8_WAIT_L(0); PG8_MMA(0, 0, At, B0); PG8_BAR; PG8_SCHED;
            PG8_LDB(B1, 1, 1); PG8_STAGEB(PG8_SB(1, 0), b3);
            PG8_BAR; PG8_WAIT_L(0); PG8_MMA(0, 1, At, B1); PG8_BAR;
            PG8_LDA(At, 1, 1); PG8_STAGE2(PG8_SA(1, 0), a3, cvo[0][0], cvo[0][1]);
            PG8_BAR; PG8_WAIT_L(0); PG8_MMA(1, 0, At, B0); PG8_BAR; PG8_SCHED;
            PG8_STAGEB(PG8_SB(1, 1), b3 + hstep);
            PG8_WAIT_V(6); PG8_BAR; PG8_MMA(1, 1, At, B1); PG8_BAR;
            }
        }
        if constexpr (ALIGN_EPI) { if (wr == 0) PG8_BAR; }
        E(acc, cur, wr, wc, fr, fq);
        if (!has_next) break;
#pragma unroll
        for (int a = 0; a < 2; ++a)
#pragma unroll
            for (int b = 0; b < 2; ++b)
#pragma unroll
                for (int m = 0; m < 4; ++m)
#pragma unroll
                    for (int n = 0; n < 2; ++n) acc[a][b][m][n] = (f32x4){0.f, 0.f, 0.f, 0.f};
        cur = nxt; cA = nA; cB = nB; ++ui;
        if constexpr (ALIGN_EPI) { if (wr == 1) PG8_BAR; }
    }
    PG8_WAIT_V(0);
    if constexpr (!ALIGN_EPI) { if (wr == 0) PG8_BAR; }
    PG8_BAR;
#undef PG8_SA
#undef PG8_SB
#undef PG8_STAGE2
#undef PG8_STAGEB
#undef PG8_LDA
#undef PG8_LDB
#undef PG8_MMA
#undef PG8_WAIT_V
#undef PG8_WAIT_L
#undef PG8_BAR
#undef PG8_SCHED
}
}

__device__ __forceinline__ void fast_moe_gateup(Frame& F, int layer) {
    const MoeTab T = moe_table(F, layer);
    pg8::MoeGuSched S; S.A = WSP(bf16, WS_HB); S.Bt = WSP(bf16, layer ? WS_GU1 : WS_GU0); S.list = WSP(int, WS_LIST); S.T = T; S.K = DM; S.G = F.G; S.c = F.bid; S.nunits = T.ts[NEXP] * 4;
    pg8::EpiGateUp E{WSP(bf16, WS_HID), WSP(float, WS_GLIST), T};
    pg8::gemm_phase<pg8::EpiGateUp, pg8::MoeGuSched, true, true>(F.lds, S, E);
}
__device__ __forceinline__ void fast_moe_down(Frame& F, int layer) {
    const MoeTab T = moe_table(F, layer);
    pg8::MoeDnSched S; S.A = WSP(bf16, WS_HID); S.Bt = WSP(bf16, layer ? WS_DN1 : WS_DN0); S.T = T; S.K = FF; S.G = F.G; S.c = F.bid; S.nunits = T.ts[NEXP] * 4;
    pg8::EpiDown E{WSP(bf16, WS_OUT2), WSP(int, WS_LIST), T};
    pg8::gemm_phase<pg8::EpiDown, pg8::MoeDnSched, true, true>(F.lds, S, E);
}

constexpr int ATT_KS = 72, ATT_VS = 264;
__device__ __forceinline__ void fast_attention(Frame& F) {
    const bf16* Q = WSP(bf16, WS_Q); const bf16* Kb = WSP(bf16, WS_K); const bf16* Vb = WSP(bf16, WS_V); bf16* O = WSP(bf16, WS_O); float* lse = WSP(float, WS_LSE);
    const float* relb = F.in[12];
    LAS bf16* Ks = (LAS bf16*)F.lds; LAS bf16* VT = (LAS bf16*)(F.lds + 256 * ATT_KS * 2); LAS float* biasv = (LAS float*)(F.lds + 256 * ATT_KS * 2 + 64 * ATT_VS * 2);
    const int lane = F.lane, w = F.wave, l15 = lane & 15, g4 = lane >> 4, wlo = w < 6 ? w : 6;
    for (int u = F.bid; u < BATCH * AH * 16; u += F.G) {
        const int x = u & 15, hd = (u >> 4) & 15, b = u >> 8;
        const int dil = hd < 6 ? 1 : (hd < 11 ? 4 : 16), nb = 16 / dil, n = x % nb, r = x / nb;
        const size_t rowb = (size_t)b * SEQ;
        __syncthreads();
#pragma unroll
        for (int c = 0; c < 4; ++c) {
            const int ch = F.tid + 512 * c, kk = ch >> 3, part = ch & 7, jk = n * 128 - 128 + kk;
            v4u kv = (v4u){0u, 0u, 0u, 0u}, vv = (v4u){0u, 0u, 0u, 0u};
            if (jk >= 0) { const size_t off = (rowb + (size_t)jk * dil + r) * DM + hd * AD + part * 8; kv = *(const v4u*)(Kb + off); vv = *(const v4u*)(Vb + off); }
            *(LAS v4u*)(Ks + kk * ATT_KS + part * 8) = kv;
#pragma unroll
            for (int e = 0; e < 4; ++e) { VT[(part * 8 + 2 * e) * ATT_VS + kk] = (bf16)(vv[e] & 0xffffu); VT[(part * 8 + 2 * e + 1) * ATT_VS + kk] = (bf16)(vv[e] >> 16); }
        }
        if (F.tid <= 128) biasv[F.tid] = relb[t5_bucket(F.tid * dil) * AH + hd];
        const int qi = 16 * w + l15;
        const size_t qrow = rowb + (size_t)(n * 128 + qi) * dil + r;
        bf16x8 qf[2];
#pragma unroll
        for (int ks = 0; ks < 2; ++ks) qf[ks] = *(const bf16x8*)(Q + qrow * DM + hd * AD + 32 * ks + 8 * g4);
        __syncthreads();
        f32x4 sacc[10];
#pragma unroll
        for (int bi = 0; bi < 10; ++bi) { sacc[bi] = (f32x4){0.f, 0.f, 0.f, 0.f};
#pragma unroll
            for (int ks = 0; ks < 2; ++ks) { const bf16x8 kf = *(const LAS bf16x8*)(Ks + ((wlo + bi) * 16 + l15) * ATT_KS + 32 * ks + 8 * g4);
                sacc[bi] = __builtin_amdgcn_mfma_f32_16x16x32_bf16(kf, qf[ks], sacc[bi], 0, 0, 0); } }
        float mx = -INFINITY;
#pragma unroll
        for (int bi = 0; bi < 10; ++bi)
#pragma unroll
            for (int q = 0; q < 4; ++q) { const int kk = (wlo + bi) * 16 + g4 * 4 + q, delta = qi + 128 - kk; const bool ok = delta >= 0 && delta <= 128 && (n * 128 - 128 + kk) >= 0;
                const float sv = ok ? sacc[bi][q] * 0.125f + biasv[ok ? delta : 0] : -INFINITY; sacc[bi][q] = sv; mx = fmaxf(mx, sv); }
        mx = fmaxf(mx, __shfl_xor(mx, 16)); mx = fmaxf(mx, __shfl_xor(mx, 32));
        float den = 0.f;
#pragma unroll
        for (int bi = 0; bi < 10; ++bi)
#pragma unroll
            for (int q = 0; q < 4; ++q) { const float pv = __expf(sacc[bi][q] - mx); sacc[bi][q] = pv; den += pv; }
        den += __shfl_xor(den, 16); den += __shfl_xor(den, 32);
        f32x4 oacc[4];
#pragma unroll
        for (int db = 0; db < 4; ++db) oacc[db] = (f32x4){0.f, 0.f, 0.f, 0.f};
#pragma unroll
        for (int k2 = 0; k2 < 5; ++k2) {
            union { bf16x8 v; unsigned u[4]; } pf;
            pf.u[0] = pk2(sacc[2 * k2][0], sacc[2 * k2][1]); pf.u[1] = pk2(sacc[2 * k2][2], sacc[2 * k2][3]);
            pf.u[2] = pk2(sacc[2 * k2 + 1][0], sacc[2 * k2 + 1][1]); pf.u[3] = pk2(sacc[2 * k2 + 1][2], sacc[2 * k2 + 1][3]);
#pragma unroll
            for (int db = 0; db < 4; ++db) {
                union { bf16x8 v; v2u h[2]; } vf;
                const LAS bf16* vp = VT + (db * 16 + l15) * ATT_VS + (wlo + 2 * k2) * 16 + g4 * 4;
                vf.h[0] = *(const LAS v2u*)vp; vf.h[1] = *(const LAS v2u*)(vp + 16);
                oacc[db] = __builtin_amdgcn_mfma_f32_16x16x32_bf16(vf.v, pf.v, oacc[db], 0, 0, 0);
            }
        }
        const float inv = 1.0f / den;
#pragma unroll
        for (int db = 0; db < 4; ++db) { const v2u o2 = (v2u){pk2(oacc[db][0] * inv, oacc[db][1] * inv), pk2(oacc[db][2] * inv, oacc[db][3] * inv)};
            *(v2u*)(O + qrow * DM + hd * AD + db * 16 + g4 * 4) = o2; }
        if (g4 == 0) lse[qrow * AH + hd] = mx + __logf(den);
    }
}

typedef float f32x16 __attribute__((ext_vector_type(16)));
constexpr int SSD_LS = 136;
__device__ __forceinline__ void conv8x8(const bf16* zx, const float* cw, const float* cbias, size_t row0, int t0, bool first_chunk, int col0, int ch0, float (&out)[8][8]) {
    v4u raw[11];
#pragma unroll
    for (int i = 0; i < 11; ++i) { const int t = t0 - 3 + i; raw[i] = (v4u){0u, 0u, 0u, 0u};
        if (t >= 0 || !first_chunk) raw[i] = *(const v4u*)(zx + (size_t)((long)row0 + t) * LDZ + col0); }
#pragma unroll
    for (int jp = 0; jp < 4; ++jp) {
        float w0[4], w1[4];
#pragma unroll
        for (int k = 0; k < 4; ++k) { w0[k] = cw[k * CONVD + ch0 + 2 * jp]; w1[k] = cw[k * CONVD + ch0 + 2 * jp + 1]; }
        const float b0 = cbias[ch0 + 2 * jp], b1 = cbias[ch0 + 2 * jp + 1];
#pragma unroll
        for (int r = 0; r < 8; ++r) { float lo = b0, hi = b1;
#pragma unroll
            for (int k = 0; k < 4; ++k) { lo += w0[k] * bflo(raw[r + k][jp]); hi += w1[k] * bfhi(raw[r + k][jp]); }
            out[r][2 * jp] = silu_f(lo); out[r][2 * jp + 1] = silu_f(hi); }
    }
}
__device__ __forceinline__ void ssd_dt_acs(Frame& F, size_t row0, int h, float& dt0, float& dt1, float& acs0, float& acs1, float& total) {
    const bf16* zx = WSP(bf16, WS_ZX);
    const float dtb = F.in[4][h], Acoef = -__expf(F.in[5][h]);
    dt0 = softplus_f(bf2f(zx[(row0 + 2 * F.lane) * LDZ + ZX_DT + h]) + dtb); dt1 = softplus_f(bf2f(zx[(row0 + 2 * F.lane + 1) * LDZ + ZX_DT + h]) + dtb);
    const float a0 = dt0 * Acoef, a1 = dt1 * Acoef; float v = a0 + a1;
#pragma unroll
    for (int o = 1; o < 64; o <<= 1) { const float t = __shfl_up(v, o); if (F.lane >= o) v += t; }
    acs1 = v; acs0 = v - a1; total = __shfl(v, 63);
}
__device__ __forceinline__ void fast_ssd_states(Frame& F, int unit) {
    const int b = unit / (NCHK * NGRP), c = (unit / NGRP) % NCHK, g = unit % NGRP;
    const bf16* zx = WSP(bf16, WS_ZX); bf16* stg = WSP(bf16, WS_ST);
    const size_t row0 = (size_t)b * SEQ + (size_t)c * CHK;
    LAS bf16* BT = (LAS bf16*)F.lds; LAS bf16* XT = (LAS bf16*)(F.lds + 34816); LAS float* sL = (LAS float*)(F.lds + 34816 + 69632);
    const int lane = F.lane, w = F.wave, l31 = lane & 31, h5 = lane >> 5;
    __syncthreads();
    { float dt0, dt1, acs0, acs1, total; ssd_dt_acs(F, row0, g * 8 + w, dt0, dt1, acs0, acs1, total);
      sL[w * 128 + 2 * lane] = dt0 * __expf(total - acs0); sL[w * 128 + 2 * lane + 1] = dt1 * __expf(total - acs1);
      if (lane == 0) WSP(float, WS_CD)[(b * NCHK + c) * NH + g * 8 + w] = __expf(total); }
    if (F.tid < 256) { const int cg = F.tid & 15, rb = F.tid >> 4; float o[8][8];
        conv8x8(zx, F.in[2], F.in[3], row0, rb * 8, c == 0, ZX_B + g * 128 + cg * 8, 2048 + g * 128 + cg * 8, o);
#pragma unroll
        for (int e = 0; e < 8; ++e) *(LAS v4u*)(BT + (cg * 8 + e) * SSD_LS + rb * 8) = (v4u){pk2(o[0][e], o[1][e]), pk2(o[2][e], o[3][e]), pk2(o[4][e], o[5][e]), pk2(o[6][e], o[7][e])}; }
    for (int hh = 0; hh < 2; ++hh) {
        __syncthreads();
        { const int cg = F.tid & 31, rb = F.tid >> 5, hl = cg >> 3, xch = (g * 8 + hh * 4) * 64 + cg * 8; float o[8][8];
          conv8x8(zx, F.in[2], F.in[3], row0, rb * 8, c == 0, ZX_X + xch, xch, o);
          float sc[8];
#pragma unroll
          for (int r = 0; r < 8; ++r) sc[r] = sL[(hh * 4 + hl) * 128 + rb * 8 + r];
#pragma unroll
          for (int e = 0; e < 8; ++e) *(LAS v4u*)(XT + (cg * 8 + e) * SSD_LS + rb * 8) = (v4u){pk2(o[0][e] * sc[0], o[1][e] * sc[1]), pk2(o[2][e] * sc[2], o[3][e] * sc[3]), pk2(o[4][e] * sc[4], o[5][e] * sc[5]), pk2(o[6][e] * sc[6], o[7][e] * sc[7])}; }
        __syncthreads();
        const int hl = w >> 1, pb = w & 1;
        f32x16 acc[4];
#pragma unroll
        for (int nb = 0; nb < 4; ++nb)
#pragma unroll
            for (int q = 0; q < 16; ++q) acc[nb][q] = 0.f;
#pragma unroll
        for (int ks = 0; ks < 8; ++ks) { const bf16x8 xf = *(const LAS bf16x8*)(XT + (hl * 64 + pb * 32 + l31) * SSD_LS + 16 * ks + 8 * h5);
#pragma unroll
            for (int nb = 0; nb < 4; ++nb) { const bf16x8 bfr = *(const LAS bf16x8*)(BT + (nb * 32 + l31) * SSD_LS + 16 * ks + 8 * h5); acc[nb] = __builtin_amdgcn_mfma_f32_32x32x16_bf16(bfr, xf, acc[nb], 0, 0, 0); } }
        const int h = g * 8 + hh * 4 + hl, p = pb * 32 + l31;
        bf16* sp = stg + ((size_t)((b * NCHK + c) * NH + h) * HD + p) * NST;
#pragma unroll
        for (int nb = 0; nb < 4; ++nb)
#pragma unroll
            for (int rg = 0; rg < 4; ++rg) *(v2u*)(sp + nb * 32 + 8 * rg + 4 * h5) = (v2u){pk2(acc[nb][4 * rg], acc[nb][4 * rg + 1]), pk2(acc[nb][4 * rg + 2], acc[nb][4 * rg + 3])};
    }
}
__device__ __forceinline__ void fast_ssd_out(Frame& F, int unit) {
    const int b = unit / (NCHK * NGRP), c = (unit / NGRP) % NCHK, g = unit % NGRP;
    const bf16* zx = WSP(bf16, WS_ZX); const bf16* prev = WSP(bf16, WS_ST); bf16* yn = (bf16*)F.out;
    const size_t row0 = (size_t)b * SEQ + (size_t)c * CHK;
    LAS bf16* Bn = (LAS bf16*)F.lds; LAS bf16* Cn = (LAS bf16*)(F.lds + 34816); LAS bf16* XT = (LAS bf16*)(F.lds + 69632);
    LAS float* acsL = (LAS float*)(F.lds + 139264); LAS float* ldaL = acsL + 1024; LAS float* ssL = ldaL + 1024;
    const int lane = F.lane, w = F.wave, l31 = lane & 31, h5 = lane >> 5;
    __syncthreads();
    { float dt0, dt1, acs0, acs1, total; ssd_dt_acs(F, row0, g * 8 + w, dt0, dt1, acs0, acs1, total);
      acsL[w * 128 + 2 * lane] = acs0; acsL[w * 128 + 2 * lane + 1] = acs1; ldaL[w * 128 + 2 * lane] = __logf(dt0) - acs0; ldaL[w * 128 + 2 * lane + 1] = __logf(dt1) - acs1; }
    { const int which = F.tid >> 8, cg = F.tid & 15, rb = (F.tid >> 4) & 15; float o[8][8];
      conv8x8(zx, F.in[2], F.in[3], row0, rb * 8, c == 0, (which ? ZX_C : ZX_B) + g * 128 + cg * 8, 2048 + which * 512 + g * 128 + cg * 8, o);
      LAS bf16* dst = (which ? Cn : Bn) + (rb * 8) * SSD_LS + cg * 8;
#pragma unroll
      for (int r = 0; r < 8; ++r) *(LAS v4u*)(dst + r * SSD_LS) = (v4u){pk2(o[r][0], o[r][1]), pk2(o[r][2], o[r][3]), pk2(o[r][4], o[r][5]), pk2(o[r][6], o[r][7])}; }
    for (int hh = 0; hh < 2; ++hh) {
        __syncthreads();
        { const int cg = F.tid & 31, rb = F.tid >> 5, xch = (g * 8 + hh * 4) * 64 + cg * 8; float o[8][8];
          conv8x8(zx, F.in[2], F.in[3], row0, rb * 8, c == 0, ZX_X + xch, xch, o);
#pragma unroll
          for (int e = 0; e < 8; ++e) *(LAS v4u*)(XT + (cg * 8 + e) * SSD_LS + rb * 8) = (v4u){pk2(o[0][e], o[1][e]), pk2(o[2][e], o[3][e]), pk2(o[4][e], o[5][e]), pk2(o[6][e], o[7][e])}; }
        __syncthreads();
        const int hl = w >> 1, h = g * 8 + hh * 4 + hl;
        const float Dh = F.in[6][h];
        const bf16* pvb = prev + ((size_t)((b * NCHK + c) * NH + h) * HD) * NST;
        const LAS float* acsH = acsL + (hh * 4 + hl) * 128; const LAS float* ldaH = ldaL + (hh * 4 + hl) * 128;
        for (int it = 0; it < 2; ++it) {
            const int ib = (w & 1) ? (1 + it) : (it ? 3 : 0), i = ib * 32 + l31;
            const float ai = acsH[i];
            f32x16 acc[2];
#pragma unroll
            for (int pb = 0; pb < 2; ++pb)
#pragma unroll
                for (int q = 0; q < 16; ++q) acc[pb][q] = 0.f;
#pragma unroll
            for (int ks = 0; ks < 8; ++ks) { const bf16x8 cf = *(const LAS bf16x8*)(Cn + i * SSD_LS + 16 * ks + 8 * h5);
#pragma unroll
                for (int pb = 0; pb < 2; ++pb) { const bf16x8 pf = *(const bf16x8*)(pvb + (size_t)(pb * 32 + l31) * NST + 16 * ks + 8 * h5); acc[pb] = __builtin_amdgcn_mfma_f32_32x32x16_bf16(pf, cf, acc[pb], 0, 0, 0); } }
            { const float ea = __expf(ai);
#pragma unroll
              for (int pb = 0; pb < 2; ++pb)
#pragma unroll
                  for (int q = 0; q < 16; ++q) acc[pb][q] *= ea; }
            for (int jb = 0; jb <= ib; ++jb) {
                f32x16 xa;
#pragma unroll
                for (int q = 0; q < 16; ++q) xa[q] = 0.f;
#pragma unroll
                for (int ks = 0; ks < 8; ++ks) { const bf16x8 bfr = *(const LAS bf16x8*)(Bn + (jb * 32 + l31) * SSD_LS + 16 * ks + 8 * h5); const bf16x8 cf = *(const LAS bf16x8*)(Cn + i * SSD_LS + 16 * ks + 8 * h5);
                    xa = __builtin_amdgcn_mfma_f32_32x32x16_bf16(bfr, cf, xa, 0, 0, 0); }
#pragma unroll
                for (int q = 0; q < 16; ++q) { const int j = jb * 32 + (q & 3) + 8 * (q >> 2) + 4 * h5; xa[q] = (j <= i) ? xa[q] * __expf(ai + ldaH[j]) : 0.f; }
#pragma unroll
                for (int s2 = 0; s2 < 2; ++s2) {
                    union { bf16x8 v; unsigned u[4]; } gf;
#pragma unroll
                    for (int q = 0; q < 4; ++q) gf.u[q] = pk2(xa[8 * s2 + 2 * q], xa[8 * s2 + 2 * q + 1]);
#pragma unroll
                    for (int pb = 0; pb < 2; ++pb) { union { bf16x8 v; v2u hv[2]; } af; const LAS bf16* xp = XT + (hl * 64 + pb * 32 + l31) * SSD_LS + jb * 32 + 16 * s2 + 4 * h5;
                        af.hv[0] = *(const LAS v2u*)xp; af.hv[1] = *(const LAS v2u*)(xp + 8);
                        acc[pb] = __builtin_amdgcn_mfma_f32_32x32x16_bf16(af.v, gf.v, acc[pb], 0, 0, 0); }
                }
            }
            float ss = 0.f;
#pragma unroll
            for (int pb = 0; pb < 2; ++pb)
#pragma unroll
                for (int rg = 0; rg < 4; ++rg) { const int p0 = pb * 32 + 8 * rg + 4 * h5;
                    const v2u zz = *(const v2u*)(zx + (row0 + i) * LDZ + h * 64 + p0);
                    const float zf[4] = {bflo(zz.x), bfhi(zz.x), bflo(zz.y), bfhi(zz.y)}; float yv[4];
#pragma unroll
                    for (int q = 0; q < 4; ++q) { const float xr = bf2f(XT[(hl * 64 + p0 + q) * SSD_LS + i]); const float y = (acc[pb][4 * rg + q] + Dh * xr) * silu_f(zf[q]); yv[q] = y; ss += y * y; }
                    *(v2u*)(yn + (row0 + i) * DIN + h * 64 + p0) = (v2u){pk2(yv[0], yv[1]), pk2(yv[2], yv[3])}; }
            ss += __shfl_xor(ss, 32);
            if (h5 == 0) ssL[(hh * 4 + hl) * 128 + i] = ss;
        }
    }
    asm volatile("s_waitcnt vmcnt(0)" ::: "memory");
    __syncthreads();
    if (F.tid < 128) { float t = 0.f;
#pragma unroll
        for (int q = 0; q < 8; ++q) t += ssL[q * 128 + F.tid];
        acsL[F.tid] = 1.0f / sqrtf(t * (1.0f / 512.0f) + LN_EPS); }
    __syncthreads();
    const float* nw = F.in[7];
#pragma unroll 4
    for (int k = 0; k < 16; ++k) { const int q = F.tid + 512 * k, i = q >> 6, ch = g * 512 + (q & 63) * 8; const float rs = acsL[i];
        v4u* ptr = (v4u*)(yn + (row0 + i) * DIN + ch); v4u v = *ptr;
        const f32x4 n0 = *(const f32x4*)(nw + ch), n1 = *(const f32x4*)(nw + ch + 4);
        v.x = pk2(bflo(v.x) * rs * n0.x, bfhi(v.x) * rs * n0.y); v.y = pk2(bflo(v.y) * rs * n0.z, bfhi(v.y) * rs * n0.w);
        v.z = pk2(bflo(v.z) * rs * n1.x, bfhi(v.z) * rs * n1.y); v.w = pk2(bflo(v.w) * rs * n1.z, bfhi(v.w) * rs * n1.w);
        *ptr = v; }
}

struct Args { const float* in[22]; float* out; unsigned char* ws; int ph_lo, ph_hi; };

__global__ void __launch_bounds__(512, 2) mk_fwd(Args a) {
    extern __shared__ __attribute__((aligned(16))) unsigned char lds_raw[];
    Frame F;
    F.lds = (LAS unsigned char*)lds_raw;
    F.tid = threadIdx.x; F.lane = F.tid & 63; F.wave = __builtin_amdgcn_readfirstlane(F.tid >> 6); F.G = gridDim.x; F.bid = blockIdx.x;
#pragma unroll
    for (int i = 0; i < 22; ++i) F.in[i] = a.in[i];
    F.out = a.out; F.ws = a.ws; F.ctl = (unsigned*)(a.ws + WS_CTL);
    volatile LAS unsigned* MISC = (volatile LAS unsigned*)(F.lds + MISC_OFF);
    if (F.tid < 64) MISC[F.tid] = 0u;
    __syncthreads();
    const bool one_launch = (a.ph_lo == 0 && a.ph_hi == NPH);
    XcdBarrier bar; bar.bar = F.ctl + CW_BAR; bar.x = 0; bar.st = MISC + 8;
    if (one_launch) bar = xcd_barrier_post(F.ctl + CW_BAR, MISC + 8);
    const int lo = a.ph_lo, hi = a.ph_hi;
#define IN(k) (lo <= (k) && (k) < hi)
#define SEAM(k) do { if (IN(k) && IN((k) + 1)) xcd_barrier(bar); } while (0)

    if (IN(0)) { p0_prologue(F); } SEAM(0);
    if (IN(1)) {
        bf16* zx = WSP(bf16, WS_ZX);
        if (FASTP(1)) { pg8::DenseSched S; S.init(WSP(bf16, WS_XB), WSP(bf16, WS_INWT), MTOK, LDZ, DM, F.G, F.bid); pg8::EpiBf16 E{zx, LDZ, 0, 0};
            pg8::gemm_phase<pg8::EpiBf16, pg8::DenseSched, true, true>(F.lds, S, E); }
        else ref_gemm(F, WSP(bf16, WS_XB), DM, WSP(bf16, WS_INWT), DM, MTOK, LDZ, DM, [=](int m, int n, float v0, float v1) { *(unsigned*)(zx + (size_t)m * LDZ + n) = pk2(v0, v1); });
    } SEAM(1);
    if (IN(2)) { for (int u = F.bid; u < BATCH * NCHK * NGRP; u += F.G) { if (FASTP(2)) fast_ssd_states(F, u); else ref_ssd_chunk<0>(F, u); } } SEAM(2);
    if (IN(3)) { p3_scan(F); } SEAM(3);
    if (IN(4)) { for (int u = F.bid; u < BATCH * NCHK * NGRP; u += F.G) { if (FASTP(4)) fast_ssd_out(F, u); else ref_ssd_chunk<1>(F, u); } } SEAM(4);
    if (IN(5)) {
        float* pre = WSP(float, WS_PRE1); const float* x = F.in[0];
        if (FASTP(5)) { pg8::DenseSched S; S.init((const bf16*)F.out, WSP(bf16, WS_OUTWT), MTOK, DM, DIN, F.G, F.bid); pg8::EpiResF32 E{pre, x, DM};
            pg8::gemm_phase<pg8::EpiResF32, pg8::DenseSched, false, true>(F.lds, S, E); }
        else ref_gemm(F, (const bf16*)F.out, DIN, WSP(bf16, WS_OUTWT), DIN, MTOK, DM, DIN, [=](int m, int n, float v0, float v1) { const size_t o = (size_t)m * DM + n; pre[o] = DN_ALPHA * x[o] + v0; pre[o + 1] = DN_ALPHA * x[o + 1] + v1; });
    } SEAM(5);
    if (IN(6)) { p_ln_router(F, 0, WSP(float, WS_PRE1), WSP(float, WS_H1), WSP(bf16, WS_HB)); } SEAM(6);
    if (IN(7)) { if (FASTP(7)) fast_moe_gateup(F, 0); else ref_moe_gateup(F, 0); } SEAM(7);
    if (IN(8)) { if (FASTP(8)) fast_moe_down(F, 0); else ref_moe_down(F, 0); } SEAM(8);
    if (IN(9)) { p_ln_ffn(F, 0, WSP(float, WS_H1), WSP(float, WS_H2), WSP(bf16, WS_HB)); } SEAM(9);
    if (IN(10)) {
        bf16* q = WSP(bf16, WS_Q);
        if (FASTP(10)) { pg8::DenseSched S; S.init(WSP(bf16, WS_HB), WSP(bf16, WS_QKVWT), MTOK, 3 * DM, DM, F.G, F.bid); pg8::EpiBf16 E{q, DM, DM, (WS_K - WS_Q) / 2};
            pg8::gemm_phase<pg8::EpiBf16, pg8::DenseSched, true, true>(F.lds, S, E); }
        else ref_gemm(F, WSP(bf16, WS_HB), DM, WSP(bf16, WS_QKVWT), DM, MTOK, 3 * DM, DM, [=](int m, int n, float v0, float v1) { *(unsigned*)(q + (size_t)(n >> 10) * ((WS_K - WS_Q) / 2) + (size_t)m * DM + (n & 1023)) = pk2(v0, v1); });
    } SEAM(10);
    if (IN(11)) { if (FASTP(11)) fast_attention(F); else ref_attention(F); } SEAM(11);
    if (IN(12)) { p_attn_rescale(F); } SEAM(12);
    if (IN(13)) {
        float* pre = WSP(float, WS_PRE2); const float* h2 = WSP(float, WS_H2);
        if (FASTP(13)) { pg8::DenseSched S; S.init(WSP(bf16, WS_O), WSP(bf16, WS_OWT), MTOK, DM, DM, F.G, F.bid); pg8::EpiResF32 E{pre, h2, DM};
            pg8::gemm_phase<pg8::EpiResF32, pg8::DenseSched, false, true>(F.lds, S, E); }
        else ref_gemm(F, WSP(bf16, WS_O), DM, WSP(bf16, WS_OWT), DM, MTOK, DM, DM, [=](int m, int n, float v0, float v1) { const size_t o = (size_t)m * DM + n; pre[o] = DN_ALPHA * h2[o] + v0; pre[o + 1] = DN_ALPHA * h2[o + 1] + v1; });
    } SEAM(13);
    if (IN(14)) { p_ln_router(F, 1, WSP(float, WS_PRE2), WSP(float, WS_H1), WSP(bf16, WS_HB)); } SEAM(14);
    if (IN(15)) { if (FASTP(15)) fast_moe_gateup(F, 1); else ref_moe_gateup(F, 1); } SEAM(15);
    if (IN(16)) { if (FASTP(16)) fast_moe_down(F, 1); else ref_moe_down(F, 1); } SEAM(16);
    if (IN(17)) { p_ln_ffn(F, 1, WSP(float, WS_H1), F.out, nullptr); }
#undef IN
#undef SEAM
}

extern "C" void kernel_launch(void* const* d_in, const int* in_sizes, int n_in, void* d_out, int out_size, void* d_ws, size_t ws_size, hipStream_t stream) {
    static int grid = 0;
    if (grid == 0) {
        if (n_in != 22 || out_size != MTOK * DM || ws_size < WS_END) { fprintf(stderr, "kernel_launch: unexpected shapes (n_in %d out %d ws %zu)\n", n_in, out_size, ws_size); grid = -1; return; }
        int dev = 0, cus = 0, per_cu = 0;
        (void)hipGetDevice(&dev); (void)hipDeviceGetAttribute(&cus, hipDeviceAttributeMultiprocessorCount, dev);
        if (hipFuncSetAttribute((const void*)mk_fwd, hipFuncAttributeMaxDynamicSharedMemorySize, LDS_BYTES) != hipSuccess) { fprintf(stderr, "kernel_launch: hipFuncSetAttribute failed\n"); grid = -1; return; }
        (void)hipOccupancyMaxActiveBlocksPerMultiprocessor(&per_cu, (const void*)mk_fwd, 512, LDS_BYTES);
        (void)hipGetLastError();
        if (per_cu < 1) fprintf(stderr, "kernel_launch: occupancy query says %d\n", per_cu);
        grid = cus;
    }
    if (grid < 0) return;
    (void)hipMemsetAsync((char*)d_ws + WS_CTL, 0, CTL_ZERO_BYTES, stream);
    Args a{};
    for (int i = 0; i < 22; ++i) a.in[i] = (const float*)d_in[i];
    a.out = (float*)d_out; a.ws = (unsigned char*)d_ws;
#ifndef MK_PER_PHASE
#define MK_PER_PHASE 0
#endif
    if (MK_PER_PHASE) {
        for (int p = 0; p < NPH; ++p) { a.ph_lo = p; a.ph_hi = p + 1; hipLaunchKernelGGL(mk_fwd, dim3(grid), dim3(512), LDS_BYTES, stream, a); }
    } else {
        a.ph_lo = 0; a.ph_hi = NPH; hipLaunchKernelGGL(mk_fwd, dim3(grid), dim3(512), LDS_BYTES, stream, a);
    }
}
```

```cpp
#include <hip/hip_runtime.h>
#include <cstdio>
#include <cstdint>

constexpr int BATCH = 8, SEQ = 2048, DM = 1024, MTOK = BATCH * SEQ;
constexpr int DIN = 2048, NH = 32, HD = 64, NGRP = 4, NST = 128, CHK = 128, NCHK = SEQ / CHK, CONVD = 3072, INDIM = 5152, LDZ = 5376;
constexpr int ZX_X = 2048, ZX_B = 4096, ZX_C = 4608, ZX_DT = 5120;
constexpr int AH = 16, AD = 64;
constexpr int NEXP = 32, FF = 512, LISTCAP = MTOK;
constexpr float DN_ALPHA = 1.41421356237309515f, LN_EPS = 1e-5f;
constexpr int NPH = 18;
#ifndef FAST_MASK
#define FAST_MASK 0x1EDF6u
#endif
#define FASTP(k) ((FAST_MASK >> (k)) & 1u)
#ifndef PROBE_A
#define PROBE_A -1
#endif
#ifndef PROBE_B
#define PROBE_B -1
#endif
#define PROBE_MULT (PROBE_A >= 100 ? 100 : 10)
constexpr int CW_PROBE = 8192;

constexpr size_t MiB = 1u << 20;
constexpr size_t WS_CTL = 0, CTL_ZERO_BYTES = 1 * MiB;
constexpr size_t WS_LIST = 1 * MiB, WS_GLIST = 3 * MiB;
constexpr size_t WS_CD = 5 * MiB;
constexpr size_t WS_RW = 5 * MiB + 65536;
constexpr size_t WS_LSE = 6 * MiB;
constexpr size_t WS_INWT = 8 * MiB, WS_OUTWT = 19 * MiB, WS_QKVWT = 23 * MiB, WS_OWT = 29 * MiB;
constexpr size_t WS_GU0 = 32 * MiB, WS_DN0 = 96 * MiB, WS_GU1 = 128 * MiB, WS_DN1 = 192 * MiB;
constexpr size_t WS_XB = 224 * MiB, WS_ZX = 256 * MiB, WS_ST = 424 * MiB;
constexpr size_t WS_PRE1 = 224 * MiB, WS_H1 = 288 * MiB, WS_HB = 352 * MiB, WS_HID = 384 * MiB, WS_OUT2 = 424 * MiB;
constexpr size_t WS_H2 = 224 * MiB, WS_Q = 384 * MiB, WS_K = 416 * MiB, WS_V = 448 * MiB, WS_O = 480 * MiB, WS_PRE2 = 288 * MiB;
constexpr size_t WS_END = 512 * MiB;
constexpr int CW_BAR = 4096;
constexpr int CW_CNT = 16384;

constexpr int LDS_BYTES = 159744;
constexpr int MISC_OFF = 155648;

#define GAS __attribute__((address_space(1)))
#define LAS __attribute__((address_space(3)))
typedef unsigned short bf16;
typedef unsigned v4u __attribute__((ext_vector_type(4)));
typedef unsigned v2u __attribute__((ext_vector_type(2)));
typedef float f32x4 __attribute__((ext_vector_type(4)));
typedef short bf16x8 __attribute__((ext_vector_type(8)));

__device__ __forceinline__ float bf2f(unsigned v) { return __uint_as_float(v << 16); }
__device__ __forceinline__ float bflo(unsigned w) { return __uint_as_float(w << 16); }
__device__ __forceinline__ float bfhi(unsigned w) { return __uint_as_float(w & 0xffff0000u); }
__device__ __forceinline__ unsigned f2bf(float f) { unsigned u = __float_as_uint(f); return (u + 0x7fffu + ((u >> 16) & 1u)) >> 16; }
typedef __bf16 bf16x2_t __attribute__((ext_vector_type(2)));
typedef float f32x2_t __attribute__((ext_vector_type(2)));
__device__ __forceinline__ unsigned pk2(float lo, float hi) { const f32x2_t v = {lo, hi}; return __builtin_bit_cast(unsigned, __builtin_convertvector(v, bf16x2_t)); }
__device__ __forceinline__ float silu_f(float x) { return x * __builtin_amdgcn_rcpf(1.0f + __expf(-x)); }
__device__ __forceinline__ float softplus_f(float x) { return fmaxf(x, 0.f) + log1pf(__expf(-fabsf(x))); }
__device__ __forceinline__ float wave_sum(float v) {
#pragma unroll
    for (int o = 1; o < 64; o <<= 1) v += __shfl_xor(v, o);
    return v;
}

#define XB_TMO      128
#define XB_XCNT(j)  (256  + 64 * (j))
#define XB_XSUB(j)  (1280 + 64 * (j))
#define XB_XGEN(j)  (2304 + 64 * (j))
#define XB_TOP      3328
#define XB_TOPGEN   3392
#define XCD_BAR_WORDS 3456
#define XB_SPIN_CAP (1u << 22)

__device__ __forceinline__ unsigned xb_ld(unsigned* p)              { return __hip_atomic_load(p, __ATOMIC_RELAXED, __HIP_MEMORY_SCOPE_AGENT); }
__device__ __forceinline__ unsigned xb_add(unsigned* p, unsigned v) { return __hip_atomic_fetch_add(p, v, __ATOMIC_RELAXED, __HIP_MEMORY_SCOPE_AGENT); }
__device__ __forceinline__ unsigned xb_xcc_id() { return (unsigned)__builtin_amdgcn_s_getreg((3 << 11) | 20) & 0xFu; }
#define XB_SPIN(cond, bar) do { unsigned _sp = 0; while (cond) { __builtin_amdgcn_s_sleep(1); \
    if ((++_sp & 255u) == 0u) { if (xb_ld(&(bar)[XB_TMO])) break; if (_sp > XB_SPIN_CAP) { atomicAdd(&(bar)[XB_TMO], 1u); break; } } } } while (0)

struct XcdBarrier { unsigned* bar; unsigned x; volatile LAS unsigned* st; };

__device__ __forceinline__ XcdBarrier xcd_barrier_post(unsigned* bar, volatile LAS unsigned* st) {
    XcdBarrier b; b.bar = bar; b.x = xb_xcc_id(); b.st = st;
    if (threadIdx.x == 0) (void)xb_add(&bar[XB_XCNT(b.x)], 1u);
    return b;
}
__device__ __forceinline__ void xcd_barrier_complete(unsigned* bar, unsigned x, unsigned& nloc, unsigned& nx) {
    const unsigned G = gridDim.x * gridDim.y * gridDim.z;
    unsigned sum, cnt, mine, sp = 0u;
    for (;;) {
        sum = 0u; cnt = 0u; mine = 0u;
#pragma unroll
        for (unsigned j = 0; j < 16; ++j) { const unsigned c = xb_ld(&bar[XB_XCNT(j)]); sum += c; cnt += (c > 0u) ? 1u : 0u; mine = (j == x) ? c : mine; }
        if (sum == G) break;
        __builtin_amdgcn_s_sleep(1);
        if ((++sp & 255u) == 0u) { if (xb_ld(&bar[XB_TMO])) break; if (sp > XB_SPIN_CAP) { atomicAdd(&bar[XB_TMO], 1u); break; } }
    }
    nloc = mine > 0u ? mine : 1u; nx = cnt > 0u ? cnt : 1u;
}
__device__ __forceinline__ void xcd_barrier(const XcdBarrier& b) {
    asm volatile("s_waitcnt vmcnt(0)" ::: "memory");
    __syncthreads();
    if (threadIdx.x == 0) {
        unsigned* bar = b.bar;
        __builtin_amdgcn_s_waitcnt(0);
        unsigned nloc = b.st[0], nx = b.st[1];
        if (nloc == 0u) { xcd_barrier_complete(bar, b.x, nloc, nx); b.st[0] = nloc; b.st[1] = nx; }
        const unsigned old = xb_add(&bar[XB_XSUB(b.x)], 1u);
        const unsigned gen = old / nloc;
        if (old + 1u == (gen + 1u) * nloc) {
            __builtin_amdgcn_fence(__ATOMIC_RELEASE, "agent");
            asm volatile("s_waitcnt vmcnt(0)" ::: "memory");
            const unsigned og = xb_add(&bar[XB_TOP], 1u);
            const unsigned tg = og / nx;
            if (og + 1u == (tg + 1u) * nx) xb_add(&bar[XB_TOPGEN], 1u);
            else XB_SPIN(xb_ld(&bar[XB_TOPGEN]) == tg, bar);
            __builtin_amdgcn_fence(__ATOMIC_ACQUIRE, "agent");
            xb_add(&bar[XB_XGEN(b.x)], 1u);
            asm volatile("s_waitcnt vmcnt(0)" ::: "memory");
        } else {
            XB_SPIN(xb_ld(&bar[XB_XGEN(b.x)]) == gen, bar);
            __builtin_amdgcn_fence(__ATOMIC_ACQUIRE, "agent");
            asm volatile("s_waitcnt vmcnt(0)" ::: "memory");
        }
    }
    __syncthreads();
}

struct Frame {
    LAS unsigned char* lds;
    int tid, lane, wave, G, bid;
    const float* in[22];
    float* out;
    unsigned char* ws;
    unsigned* ctl;
};
#define WSP(T, off) ((T*)(F.ws + (off)))

__device__ __forceinline__ int t5_bucket(int dist) {
    if (dist < 16) return dist;
    int b = 16;
    b += dist >= 22; b += dist >= 30; b += dist >= 40; b += dist >= 54; b += dist >= 73; b += dist >= 99; b += dist >= 134; b += dist >= 182;
    b += dist >= 246; b += dist >= 332; b += dist >= 450; b += dist >= 609; b += dist >= 825; b += dist >= 1117; b += dist >= 1513;
    return b;
}

struct P0Item { const float* W; bf16* WT; int N, k0, n0, ldt, drow0; };
__device__ __forceinline__ P0Item p0_item(Frame& F, int it) {
    constexpr int I_IN = 16 * 161, I_OUT = 32 * 32, I_KV = 16 * 64, I_Q = 16 * 32, I_O = 16 * 32, I_MOE = 2 * 32 * 256;
    P0Item d; int r = it;
    if (r < I_IN) { const int kb = r / 161, nb = r % 161; d = P0Item{F.in[1], WSP(bf16, WS_INWT), INDIM, kb * 64, nb * 32, DM, nb * 32}; return d; } r -= I_IN;
    if (r < I_OUT) { const int kb = r / 32, nb = r % 32; d = P0Item{F.in[8], WSP(bf16, WS_OUTWT), DM, kb * 64, nb * 32, DIN, nb * 32}; return d; } r -= I_OUT;
    if (r < I_KV) { const int kb = r / 64, nb = r % 64; d = P0Item{F.in[9], WSP(bf16, WS_QKVWT), 2048, kb * 64, nb * 32, DM, 1024 + nb * 32}; return d; } r -= I_KV;
    if (r < I_Q) { const int kb = r / 32, nb = r % 32; d = P0Item{F.in[10], WSP(bf16, WS_QKVWT), DM, kb * 64, nb * 32, DM, nb * 32}; return d; } r -= I_Q;
    if (r < I_O) { const int kb = r / 32, nb = r % 32; d = P0Item{F.in[11], WSP(bf16, WS_OWT), DM, kb * 64, nb * 32, DM, nb * 32}; return d; } r -= I_O;
    if (r < 2 * I_MOE) {
        const int isup = r / I_MOE; r -= isup * I_MOE;
        const int le = r / 256, q = r % 256, kb = q / 16, nb = q % 16, l = le / 32, e = le % 32, n0 = nb * 32;
        d = P0Item{F.in[isup ? 18 : 17] + (size_t)le * DM * FF, WSP(bf16, l ? WS_GU1 : WS_GU0) + (size_t)e * 1024 * DM, FF, kb * 64, n0, DM, (n0 >> 7) * 256 + (n0 & 127) + isup * 128}; return d; }
    r -= 2 * I_MOE;
    { const int le = r / 256, q = r % 256, kb = q / 32, nb = q % 32, l = le / 32, e = le % 32;
      d = P0Item{F.in[19] + (size_t)le * FF * DM, WSP(bf16, l ? WS_DN1 : WS_DN0) + (size_t)e * DM * FF, DM, kb * 64, nb * 32, FF, nb * 32}; return d; }
}
__device__ __forceinline__ void p0_item_load(const P0Item& d, int lane, f32x4 (&v)[8]) {
#pragma unroll
    for (int i = 0; i < 8; ++i) v[i] = *(const f32x4*)(d.W + (size_t)(d.k0 + 8 * i + (lane >> 3)) * d.N + d.n0 + 4 * (lane & 7));
}
__device__ __forceinline__ void p0_item_store(const P0Item& d, int lane, const f32x4 (&v)[8], LAS float* scr) {
#pragma unroll
    for (int i = 0; i < 8; ++i) { LAS float* p = scr + (8 * i + (lane >> 3)) * 33 + 4 * (lane & 7); p[0] = v[i].x; p[1] = v[i].y; p[2] = v[i].z; p[3] = v[i].w; }
    asm volatile("s_waitcnt lgkmcnt(0)" ::: "memory");
    const int c = lane & 7;
#pragma unroll
    for (int j = 0; j < 4; ++j) { const int n = (lane >> 3) + 8 * j; const LAS float* s = scr + (8 * c) * 33 + n;
        v4u o; o.x = pk2(s[0 * 33], s[1 * 33]); o.y = pk2(s[2 * 33], s[3 * 33]); o.z = pk2(s[4 * 33], s[5 * 33]); o.w = pk2(s[6 * 33], s[7 * 33]);
        *(v4u*)(d.WT + (size_t)(d.drow0 + n) * d.ldt + d.k0 + 8 * c) = o; }
    asm volatile("s_waitcnt lgkmcnt(0)" ::: "memory");
}
constexpr int P0_DENSE = 16 * 161 + 32 * 32 + 16 * 64 + 16 * 32 + 16 * 32;
constexpr int CW_QHEAD = 12288;
__device__ __forceinline__ int p0_map0(int i) { return i; }
__device__ __forceinline__ int p0_map1(int q) { return P0_DENSE + (q >> 13) * 16384 + 8192 + (q & 8191); }
__device__ __forceinline__ void p0_drain(Frame& F) {
    LAS float* scr = (LAS float*)(F.lds + F.wave * 16384);
    unsigned* head = F.ctl + CW_QHEAD;
    int lane = threadIdx.x & 63; asm volatile("" : "+v"(lane));
    for (;;) {
        unsigned q = 0; if (lane == 0) q = atomicAdd(head, 2u);
        q = (unsigned)__builtin_amdgcn_readfirstlane((int)q);
        if (q >= 24576u) break;
        f32x4 va[8], vb[8];
        const P0Item da = p0_item(F, p0_map1((int)q)), db = p0_item(F, p0_map1((int)q + 1));
        p0_item_load(da, lane, va); p0_item_load(db, lane, vb);
        p0_item_store(da, lane, va, scr); p0_item_store(db, lane, vb, scr);
    }
}
__device__ __forceinline__ void p0_prologue(Frame& F) {
    LAS float* scr = (LAS float*)(F.lds + F.wave * 16384);
    const int gw = F.bid * 8 + F.wave, NGW = F.G * 8;
    constexpr int N0 = P0_DENSE + 3 * 16384;
    if (gw < N0) {
        f32x4 va[8], vb[8];
        P0Item da = p0_item(F, p0_map0(gw)), db = da;
        p0_item_load(da, F.lane, va);
        for (int it = gw; it < N0; it += 2 * NGW) {
            const bool hb = it + NGW < N0;
            if (hb) { db = p0_item(F, p0_map0(it + NGW)); p0_item_load(db, F.lane, vb); }
            p0_item_store(da, F.lane, va, scr);
            const bool ha = it + 2 * NGW < N0;
            if (ha) { da = p0_item(F, p0_map0(it + 2 * NGW)); p0_item_load(da, F.lane, va); }
            if (hb) p0_item_store(db, F.lane, vb, scr);
        }
    }
    const int gt = F.bid * 512 + F.tid, NGT = F.G * 512;
#pragma unroll 4
    for (int i = gt; i < MTOK * DM / 8; i += NGT) {
        const f32x4 a = ((const f32x4*)F.in[0])[2 * i], b = ((const f32x4*)F.in[0])[2 * i + 1];
        v4u o; o.x = pk2(a.x, a.y); o.y = pk2(a.z, a.w); o.z = pk2(b.x, b.y); o.w = pk2(b.z, b.w);
        WSP(v4u, WS_XB)[i] = o;
    }
    for (int i = gt; i < 2 * 48 * DM; i += NGT) { const int k = i & (DM - 1), col = (i >> 10) % 48, l = i / (48 * DM);
        float wv = 0.f;
        if (col < 32) wv = F.in[15][(((size_t)l * 4 + (col >> 3)) * DM + k) * 8 + (col & 7)]; else if (col < 36) wv = F.in[13][((size_t)l * DM + k) * 4 + (col - 32)];
        const unsigned hi = f2bf(wv), lo = f2bf(wv - bf2f(hi));
        bf16* base = WSP(bf16, WS_RW) + (size_t)l * 2 * 48 * DM + (size_t)col * DM + k; base[0] = (bf16)hi; base[48 * DM] = (bf16)lo; }
    for (int i = gt; i < (LDZ - INDIM) * DM / 8; i += NGT) (WSP(v4u, WS_INWT) + (size_t)INDIM * DM / 8)[i] = (v4u){0u, 0u, 0u, 0u};
}

__device__ __forceinline__ void dot4x2(const bf16* a0, const bf16* a1, const bf16* a2, const bf16* a3, const bf16* b0, const bf16* b1, int K, float (&acc)[4][2]) {
    for (int k = 0; k < K; k += 8) {
        const v4u A0 = *(const v4u*)(a0 + k), A1 = *(const v4u*)(a1 + k), A2 = *(const v4u*)(a2 + k), A3 = *(const v4u*)(a3 + k);
        const v4u B0 = *(const v4u*)(b0 + k), B1 = *(const v4u*)(b1 + k);
#pragma unroll
        for (int j = 0; j < 4; ++j) {
            const float b0l = bflo(B0[j]), b0h = bfhi(B0[j]), b1l = bflo(B1[j]), b1h = bfhi(B1[j]);
            acc[0][0] += bflo(A0[j]) * b0l + bfhi(A0[j]) * b0h; acc[0][1] += bflo(A0[j]) * b1l + bfhi(A0[j]) * b1h;
            acc[1][0] += bflo(A1[j]) * b0l + bfhi(A1[j]) * b0h; acc[1][1] += bflo(A1[j]) * b1l + bfhi(A1[j]) * b1h;
            acc[2][0] += bflo(A2[j]) * b0l + bfhi(A2[j]) * b0h; acc[2][1] += bflo(A2[j]) * b1l + bfhi(A2[j]) * b1h;
            acc[3][0] += bflo(A3[j]) * b0l + bfhi(A3[j]) * b0h; acc[3][1] += bflo(A3[j]) * b1l + bfhi(A3[j]) * b1h;
        }
    }
}
template <class Epi>
__device__ __forceinline__ void ref_gemm(Frame& F, const bf16* A, int lda, const bf16* Bt, int ldb, int M, int N, int K, const Epi& epi) {
    const int tx = F.tid & 63, ty = F.tid >> 6, ntn = N / 128, ntiles = (M / 32) * ntn;
    for (int t = F.bid; t < ntiles; t += F.G) {
        const int m0 = (t / ntn) * 32 + ty * 4, n0 = (t % ntn) * 128 + tx * 2;
        float acc[4][2] = {};
        const bf16* ap = A + (size_t)m0 * lda; const bf16* bp = Bt + (size_t)n0 * ldb;
        dot4x2(ap, ap + lda, ap + 2 * lda, ap + 3 * lda, bp, bp + ldb, K, acc);
#pragma unroll
        for (int r = 0; r < 4; ++r) epi(m0 + r, n0, acc[r][0], acc[r][1]);
    }
}

template <int MODE>
__device__ __forceinline__ void ref_ssd_chunk(Frame& F, int unit) {
    const int b = unit / (NCHK * NGRP), c = (unit / NGRP) % NCHK, g = unit % NGRP;
    const int hl = F.tid >> 6, p = F.tid & 63, h = g * 8 + hl, xch = h * 64 + p;
    const bf16* zx = WSP(bf16, WS_ZX);
    const float* cw = F.in[2]; const float* cbias = F.in[3];
    LAS float* bcL = (LAS float*)F.lds;
    LAS float* red = (LAS float*)(F.lds + 1024);
    float st[NST];
    const size_t sbase = ((size_t)((b * NCHK + c) * NH + h) * HD + p) * NST;
    bf16* stg = WSP(bf16, WS_ST);
    if (MODE == 1) {
#pragma unroll
        for (int n = 0; n < NST; n += 8) { const v4u v = *(const v4u*)(stg + sbase + n);
#pragma unroll
            for (int j = 0; j < 4; ++j) { st[n + 2 * j] = bflo(v[j]); st[n + 2 * j + 1] = bfhi(v[j]); } }
    } else {
#pragma unroll
        for (int n = 0; n < NST; ++n) st[n] = 0.f;
    }
    const int xcol = ZX_X + xch;
    const float xw0 = cw[0 * CONVD + xch], xw1 = cw[1 * CONVD + xch], xw2 = cw[2 * CONVD + xch], xw3 = cw[3 * CONVD + xch], xb_ = cbias[xch];
    const int bcch = (F.tid < 128) ? (2048 + g * 128 + F.tid) : (2048 + 512 + g * 128 + (F.tid - 128));
    const int bccol = ZX_X + bcch;
    float bw0 = 0, bw1 = 0, bw2 = 0, bw3 = 0, bb_ = 0;
    if (F.tid < 256) { bw0 = cw[0 * CONVD + bcch]; bw1 = cw[1 * CONVD + bcch]; bw2 = cw[2 * CONVD + bcch]; bw3 = cw[3 * CONVD + bcch]; bb_ = cbias[bcch]; }
    const float dtb = F.in[4][h], Acoef = -__expf(F.in[5][h]), Dh = F.in[6][h], nw = F.in[7][xch];
    const size_t row0 = (size_t)b * SEQ + (size_t)c * CHK;
    float x1 = 0, x2 = 0, x3 = 0, q1 = 0, q2 = 0, q3 = 0;
    if (c > 0) {
        x1 = bf2f(zx[(row0 - 1) * LDZ + xcol]); x2 = bf2f(zx[(row0 - 2) * LDZ + xcol]); x3 = bf2f(zx[(row0 - 3) * LDZ + xcol]);
        if (F.tid < 256) { q1 = bf2f(zx[(row0 - 1) * LDZ + bccol]); q2 = bf2f(zx[(row0 - 2) * LDZ + bccol]); q3 = bf2f(zx[(row0 - 3) * LDZ + bccol]); }
    }
    float asum = 0.f;
    for (int t = 0; t < CHK; ++t) {
        const size_t row = row0 + t;
        const float x0 = bf2f(zx[row * LDZ + xcol]);
        const float xv = silu_f(xb_ + xw0 * x3 + xw1 * x2 + xw2 * x1 + xw3 * x0);
        x3 = x2; x2 = x1; x1 = x0;
        if (F.tid < 256) { const float q0 = bf2f(zx[row * LDZ + bccol]); bcL[F.tid] = silu_f(bb_ + bw0 * q3 + bw1 * q2 + bw2 * q1 + bw3 * q0); q3 = q2; q2 = q1; q1 = q0; }
        const float dtv = softplus_f(bf2f(zx[row * LDZ + ZX_DT + h]) + dtb);
        const float adt = dtv * Acoef, dA = __expf(adt);
        asum += adt;
        __syncthreads();
        const float xs = dtv * xv;
        float y = 0.f;
#pragma unroll
        for (int n = 0; n < NST; ++n) { st[n] = st[n] * dA + xs * bcL[n]; if (MODE == 1) y += bcL[128 + n] * st[n]; }
        if (MODE == 1) {
            y += Dh * xv;
            y *= silu_f(bf2f(zx[row * LDZ + xch]));
            const float ws2 = wave_sum(y * y);
            if (F.lane == 0) red[hl] = ws2;
            __syncthreads();
            float tot = 0.f;
#pragma unroll
            for (int i = 0; i < 8; ++i) tot += red[i];
            const float rs = 1.0f / sqrtf(tot * (1.0f / 512.0f) + LN_EPS);
            ((bf16*)F.out)[row * DIN + xch] = (bf16)f2bf(y * rs * nw);
        }
        __syncthreads();
    }
    if (MODE == 0) {
#pragma unroll
        for (int n = 0; n < NST; n += 8) { v4u v;
#pragma unroll
            for (int j = 0; j < 4; ++j) v[j] = pk2(st[n + 2 * j], st[n + 2 * j + 1]);
            *(v4u*)(stg + sbase + n) = v; }
        if (p == 0) WSP(float, WS_CD)[(b * NCHK + c) * NH + h] = __expf(asum);
    }
}

__device__ __forceinline__ void p3_scan(Frame& F) {
    bf16* stg = WSP(bf16, WS_ST); const float* cd = WSP(float, WS_CD);
    const int gt = F.bid * 512 + F.tid, NGT = F.G * 512;
    for (int i = gt; i < BATCH * NH * HD * (NST / 8); i += NGT) {
        const int n8 = i & 15, p = (i >> 4) & 63, h = (i >> 10) & 31, b = i >> 15;
        float carry[8] = {0, 0, 0, 0, 0, 0, 0, 0};
        for (int c = 0; c < NCHK; ++c) {
            v4u* ptr = (v4u*)(stg + ((size_t)((b * NCHK + c) * NH + h) * HD + p) * NST + n8 * 8);
            const v4u s = *ptr; const float d = cd[(b * NCHK + c) * NH + h];
            v4u o;
#pragma unroll
            for (int j = 0; j < 4; ++j) { o[j] = pk2(carry[2 * j], carry[2 * j + 1]); carry[2 * j] = carry[2 * j] * d + bflo(s[j]); carry[2 * j + 1] = carry[2 * j + 1] * d + bfhi(s[j]); }
            *ptr = o;
        }
    }
}

__device__ __forceinline__ void ln_row(f32x4 (&v)[4], const float* g, const float* bta, int lane) {
    float s = 0.f;
#pragma unroll
    for (int j = 0; j < 4; ++j) s += (v[j].x + v[j].y) + (v[j].z + v[j].w);
    const float mean = wave_sum(s) * (1.f / DM); float s2 = 0.f;
#pragma unroll
    for (int j = 0; j < 4; ++j) { v[j] = v[j] - mean; s2 += (v[j].x * v[j].x + v[j].y * v[j].y) + (v[j].z * v[j].z + v[j].w * v[j].w); }
    const float rstd = 1.0f / sqrtf(wave_sum(s2) * (1.f / DM) + LN_EPS);
#pragma unroll
    for (int j = 0; j < 4; ++j) { const f32x4 gg = ((const f32x4*)g)[lane + 64 * j], bb = ((const f32x4*)bta)[lane + 64 * j]; v[j] = v[j] * rstd * gg + bb; }
}
__device__ __forceinline__ void store_row_f32_bf16(const f32x4 (&v)[4], float* of, bf16* ob, int lane) {
#pragma unroll
    for (int j = 0; j < 4; ++j) {
        if (of) ((f32x4*)of)[lane + 64 * j] = v[j];
        if (ob) ((v2u*)ob)[lane + 64 * j] = (v2u){pk2(v[j].x, v[j].y), pk2(v[j].z, v[j].w)};
    }
}

__device__ __forceinline__ void p_ln_router(Frame& F, int layer, const float* pre, float* hf, bf16* hb) {
    const float* lg = F.in[20] + (size_t)(layer * 2 + 0) * DM; const float* lb = F.in[21] + (size_t)(layer * 2 + 0) * DM;
    const float* gw = F.in[13] + (size_t)layer * DM * 4; const float* gb = F.in[14] + layer * 4;
    const float* ew = F.in[15] + (size_t)layer * 4 * DM * 8; const float* eb = F.in[16] + layer * 32;
    unsigned* cnt = F.ctl + CW_CNT + layer * 64 * 32;
    int* list = WSP(int, WS_LIST); float* glist = WSP(float, WS_GLIST);
    const int gwv = F.bid * 8 + F.wave, NGW = F.G * 8, lane = F.lane;
    for (int tok = gwv; tok < MTOK; tok += NGW) {
        f32x4 v[4];
#pragma unroll
        for (int j = 0; j < 4; ++j) v[j] = ((const f32x4*)(pre + (size_t)tok * DM))[lane + 64 * j];
        ln_row(v, lg, lb, lane);
        store_row_f32_bf16(v, hf + (size_t)tok * DM, hb + (size_t)tok * DM, lane);
        float gl[4] = {0, 0, 0, 0};
#pragma unroll
        for (int j = 0; j < 4; ++j)
#pragma unroll
            for (int i = 0; i < 4; ++i) { const int k = 4 * lane + 256 * j + i; const f32x4 w = ((const f32x4*)gw)[k]; const float hv = v[j][i];
                gl[0] += hv * w.x; gl[1] += hv * w.y; gl[2] += hv * w.z; gl[3] += hv * w.w; }
#pragma unroll
        for (int q = 0; q < 4; ++q) gl[q] = wave_sum(gl[q]) + gb[q];
        int gi = 0; float gm = gl[0];
#pragma unroll
        for (int q = 1; q < 4; ++q) if (gl[q] > gm) { gm = gl[q]; gi = q; }
        float gden = 0.f;
#pragma unroll
        for (int q = 0; q < 4; ++q) gden += __expf(gl[q] - gm);
        const float gval = 1.0f / gden;
        float el[8] = {0, 0, 0, 0, 0, 0, 0, 0};
        const float* ewg = ew + (size_t)gi * DM * 8;
#pragma unroll
        for (int j = 0; j < 4; ++j)
#pragma unroll
            for (int i = 0; i < 4; ++i) { const int k = 4 * lane + 256 * j + i; const f32x4 w0 = ((const f32x4*)ewg)[2 * k], w1 = ((const f32x4*)ewg)[2 * k + 1]; const float hv = v[j][i];
                el[0] += hv * w0.x; el[1] += hv * w0.y; el[2] += hv * w0.z; el[3] += hv * w0.w; el[4] += hv * w1.x; el[5] += hv * w1.y; el[6] += hv * w1.z; el[7] += hv * w1.w; }
#pragma unroll
        for (int q = 0; q < 8; ++q) el[q] = wave_sum(el[q]) + eb[gi * 8 + q];
        int i1 = 0; float v1 = el[0];
#pragma unroll
        for (int q = 1; q < 8; ++q) if (el[q] > v1) { v1 = el[q]; i1 = q; }
        int i2 = -1; float v2 = -3.0e38f;
#pragma unroll
        for (int q = 0; q < 8; ++q) if (q != i1 && el[q] > v2) { v2 = el[q]; i2 = q; }
        const float e2 = __expf(v2 - v1), p1 = gval / (1.0f + e2), p2 = gval * e2 / (1.0f + e2);
        if (lane == 0) {
            if (i2 < 0) i2 = (i1 + 1) & 7;
            const int ea = gi * 8 + i1, ebx = gi * 8 + i2;
            const unsigned s1 = atomicAdd(cnt + ea * 64, 1u); list[ea * LISTCAP + s1] = tok * 2; glist[ea * LISTCAP + s1] = p1;
            const unsigned s2 = atomicAdd(cnt + ebx * 64, 1u); list[ebx * LISTCAP + s2] = tok * 2 + 1; glist[ebx * LISTCAP + s2] = p2;
        }
    }
}

struct MoeTab { volatile LAS int* ts; volatile LAS int* cn; volatile LAS int* ths; volatile LAS int* tho; volatile LAS int* tl; volatile LAS int* nth; };
__device__ __forceinline__ MoeTab moe_table(Frame& F, int layer, bool thin) {
    MoeTab T; T.ts = (volatile LAS int*)(F.lds + MISC_OFF + 256); T.cn = (volatile LAS int*)(F.lds + MISC_OFF + 512); T.ths = (volatile LAS int*)(F.lds + MISC_OFF + 640);
    T.tho = (volatile LAS int*)(F.lds + MISC_OFF + 768); T.tl = (volatile LAS int*)(F.lds + MISC_OFF + 896); T.nth = (volatile LAS int*)(F.lds + MISC_OFF + 248);
    __syncthreads();
    if (threadIdx.x < NEXP) T.cn[threadIdx.x] = (int)__hip_atomic_load(F.ctl + CW_CNT + layer * 64 * 32 + threadIdx.x * 64, __ATOMIC_RELAXED, __HIP_MEMORY_SCOPE_AGENT);
    __syncthreads();
    if (threadIdx.x == 0) { int acc = 0, nth = 0;
        for (int e = 0; e < NEXP; ++e) { const int c = T.cn[e];
            const int full = c >> 8, rem = c & 255; const bool th = thin && rem > 0 && rem <= 64;
            T.ts[e] = acc; acc += full + ((rem > 0 && !th) ? 1 : 0); T.ths[e] = th ? full * 256 : c; if (th) T.tl[nth++] = e; }
        T.ts[NEXP] = acc; T.nth[0] = nth;
        int off = acc * 256; for (int k = 0; k < nth; ++k) { const int e = T.tl[k]; T.tho[e] = off; off += T.cn[e] - T.ths[e]; } }
    __syncthreads();
    return T;
}
__device__ __forceinline__ void moe_find(const MoeTab& T, int rt, int& e, int& j) { int ee = 0; while (ee < NEXP - 1 && T.ts[ee + 1] <= rt) ++ee; e = ee; j = rt - T.ts[ee]; }

__device__ __forceinline__ void ref_moe_gateup(Frame& F, int layer) {
    const MoeTab T = moe_table(F, layer, false);
    const bf16* hb = WSP(bf16, WS_HB); const bf16* gu = WSP(bf16, layer ? WS_GU1 : WS_GU0); bf16* hid = WSP(bf16, WS_HID);
    const int* list = WSP(int, WS_LIST); const float* glist = WSP(float, WS_GLIST);
    const int nunits = T.ts[NEXP] * 4, fl = F.tid & 127, ty = F.tid >> 7;
    for (int u = F.bid; u < nunits; u += F.G) {
        const int rt = u >> 2, pn = u & 3; int e, j; moe_find(T, rt, e, j);
        const int cnt = T.cn[e];
        const bf16* bg = gu + ((size_t)e * 1024 + pn * 256 + fl) * DM; const bf16* bu = bg + (size_t)128 * DM;
        for (int rr = ty * 4; rr < 256; rr += 16) {
            const bf16* ap[4]; float gv[4];
#pragma unroll
            for (int r = 0; r < 4; ++r) { const int slot = j * 256 + rr + r; const bool ok = slot < cnt; const int pair = ok ? list[e * LISTCAP + slot] : 0; gv[r] = ok ? glist[e * LISTCAP + slot] : 0.f; ap[r] = hb + (size_t)(pair >> 1) * DM; }
            float acc[4][2] = {};
            dot4x2(ap[0], ap[1], ap[2], ap[3], bg, bu, DM, acc);
#pragma unroll
            for (int r = 0; r < 4; ++r) hid[((size_t)rt * 256 + rr + r) * FF + pn * 128 + fl] = (bf16)f2bf(silu_f(acc[r][0]) * acc[r][1] * gv[r]);
        }
    }
}
__device__ __forceinline__ void ref_moe_down(Frame& F, int layer) {
    const MoeTab T = moe_table(F, layer, false);
    const bf16* hid = WSP(bf16, WS_HID); const bf16* dn = WSP(bf16, layer ? WS_DN1 : WS_DN0); bf16* out2 = WSP(bf16, WS_OUT2);
    const int* list = WSP(int, WS_LIST);
    const int nunits = T.ts[NEXP] * 4, tx = F.tid & 127, ty = F.tid >> 7;
    for (int u = F.bid; u < nunits; u += F.G) {
        const int rt = u >> 2, pn = u & 3; int e, j; moe_find(T, rt, e, j);
        const int cnt = T.cn[e];
        const bf16* b0 = dn + ((size_t)e * DM + pn * 256 + tx * 2) * FF; const bf16* b1 = b0 + FF;
        for (int rr = ty * 4; rr < 256; rr += 16) {
            const bf16* a0 = hid + ((size_t)rt * 256 + rr) * FF;
            float acc[4][2] = {};
            dot4x2(a0, a0 + FF, a0 + 2 * FF, a0 + 3 * FF, b0, b1, FF, acc);
#pragma unroll
            for (int r = 0; r < 4; ++r) { const int slot = j * 256 + rr + r; if (slot < cnt) { const int pair = list[e * LISTCAP + slot];
                *(unsigned*)(out2 + (size_t)pair * DM + pn * 256 + tx * 2) = pk2(acc[r][0], acc[r][1]); } }
        }
    }
}
__device__ __forceinline__ void p_ln_ffn(Frame& F, int layer, const float* hf, float* of, bf16* ob) {
    const float* lg = F.in[20] + (size_t)(layer * 2 + 1) * DM; const float* lb = F.in[21] + (size_t)(layer * 2 + 1) * DM;
    const bf16* out2 = WSP(bf16, WS_OUT2);
    const int gwv = F.bid * 8 + F.wave, NGW = F.G * 8, lane = F.lane;
    for (int tok = gwv; tok < MTOK; tok += NGW) {
        f32x4 v[4];
#pragma unroll
        for (int j = 0; j < 4; ++j) {
            const f32x4 hv = ((const f32x4*)(hf + (size_t)tok * DM))[lane + 64 * j];
            const v2u a = ((const v2u*)(out2 + (size_t)(2 * tok) * DM))[lane + 64 * j], b = ((const v2u*)(out2 + (size_t)(2 * tok + 1) * DM))[lane + 64 * j];
            v[j].x = DN_ALPHA * hv.x + (bflo(a.x) + bflo(b.x)); v[j].y = DN_ALPHA * hv.y + (bfhi(a.x) + bfhi(b.x));
            v[j].z = DN_ALPHA * hv.z + (bflo(a.y) + bflo(b.y)); v[j].w = DN_ALPHA * hv.w + (bfhi(a.y) + bfhi(b.y));
        }
        ln_row(v, lg, lb, lane);
        store_row_f32_bf16(v, of + (size_t)tok * DM, ob ? ob + (size_t)tok * DM : nullptr, lane);
    }
}

__device__ __forceinline__ void ref_attention(Frame& F) {
    const bf16* Q = WSP(bf16, WS_Q); const bf16* Kb = WSP(bf16, WS_K); const bf16* Vb = WSP(bf16, WS_V); bf16* O = WSP(bf16, WS_O); float* lse = WSP(float, WS_LSE);
    const float* relb = F.in[12];
    const int gt = F.bid * 512 + F.tid, NGT = F.G * 512;
    for (int i = gt; i < MTOK * AH; i += NGT) {
        const int hd = i & 15, row = i >> 4, t = row & (SEQ - 1), rb = row - t;
        const int dil = hd < 6 ? 1 : (hd < 11 ? 4 : 16);
        float q[AD], o[AD];
#pragma unroll
        for (int d = 0; d < AD; d += 8) { const v4u v = *(const v4u*)(Q + (size_t)row * DM + hd * AD + d);
#pragma unroll
            for (int j = 0; j < 4; ++j) { q[d + 2 * j] = bflo(v[j]); q[d + 2 * j + 1] = bfhi(v[j]); } }
#pragma unroll
        for (int d = 0; d < AD; ++d) o[d] = 0.f;
        float m = -3.0e38f, l = 0.f;
        for (int delta = 0; delta <= 128; ++delta) {
            const int kt = t - delta * dil; if (kt < 0) break;
            const size_t kr = (size_t)(rb + kt) * DM + hd * AD;
            float s = 0.f;
#pragma unroll
            for (int d = 0; d < AD; d += 8) { const v4u v = *(const v4u*)(Kb + kr + d);
#pragma unroll
                for (int j = 0; j < 4; ++j) s += q[d + 2 * j] * bflo(v[j]) + q[d + 2 * j + 1] * bfhi(v[j]); }
            s = s * 0.125f + relb[t5_bucket(delta * dil) * AH + hd];
            const float mn = fmaxf(m, s), sc = __expf(m - mn), pw = __expf(s - mn);
            l = l * sc + pw; m = mn;
#pragma unroll
            for (int d = 0; d < AD; d += 8) { const v4u v = *(const v4u*)(Vb + kr + d);
#pragma unroll
                for (int j = 0; j < 4; ++j) { o[d + 2 * j] = o[d + 2 * j] * sc + pw * bflo(v[j]); o[d + 2 * j + 1] = o[d + 2 * j + 1] * sc + pw * bfhi(v[j]); } }
        }
        const float inv = 1.0f / l;
#pragma unroll
        for (int d = 0; d < AD; d += 8) { v4u v;
#pragma unroll
            for (int j = 0; j < 4; ++j) v[j] = pk2(o[d + 2 * j] * inv, o[d + 2 * j + 1] * inv);
            *(v4u*)(O + (size_t)row * DM + hd * AD + d) = v; }
        lse[(size_t)row * AH + hd] = m + __logf(l);
    }
}
__device__ __forceinline__ void p_attn_rescale(Frame& F) {
    bf16* O = WSP(bf16, WS_O); const float* lse = WSP(float, WS_LSE);
    const int gwv = F.bid * 8 + F.wave, NGW = F.G * 8, lane = F.lane;
    for (int row = gwv; row < MTOK; row += NGW) {
        const float lv = lane < 16 ? lse[(size_t)row * AH + lane] : 0.f;
        float s0 = 0.f, s1 = 0.f, s2 = 0.f;
#pragma unroll
        for (int hh = 0; hh < 16; ++hh) { const float x = __shfl(lv, hh); if (hh < 6) s0 += x; else if (hh < 11) s1 += x; else s2 += x; }
        s0 *= (1.f / 6.f); s1 *= 0.2f; s2 *= 0.2f;
        const float mx = fmaxf(s0, fmaxf(s1, s2)), e0 = __expf(s0 - mx), e1 = __expf(s1 - mx), e2 = __expf(s2 - mx), inv = 3.0f / (e0 + e1 + e2);
        const int hd = lane >> 2; const float w = (hd < 6 ? e0 : (hd < 11 ? e1 : e2)) * inv;
        v4u* p = (v4u*)(O + (size_t)row * DM + lane * 16);
#pragma unroll
        for (int c = 0; c < 2; ++c) { v4u v = p[c];
#pragma unroll
            for (int j = 0; j < 4; ++j) v[j] = pk2(bflo(v[j]) * w, bfhi(v[j]) * w);
            p[c] = v; }
    }
}

namespace pg8 {
constexpr int BM = 256, BK = 64, HALF = 128, HTB = HALF * BK * 2, STAGE_BYTES = 8 * HTB, NXCD = 8, WGM = 8;
__host__ __device__ __forceinline__ int lds_byte(int r, int c) { const int st = (r >> 4) * 2 + (c >> 5), rr = r & 15, cc = c & 31, ob = rr * 64 + cc * 2; return st * 1024 + (ob ^ (((ob >> 9) & 1) << 5)); }
__host__ __device__ __forceinline__ void stage_rc(int b, int& R, int& C) { const int st = b / 1024, sb = b % 1024, swz = sb ^ (((sb >> 9) & 1) << 5); R = (st >> 1) * 16 + swz / 64; C = (st & 1) * 32 + (swz % 64) / 2; }
__host__ __device__ __forceinline__ int perm32(int rho) { const int n = rho >> 4, i = rho & 15; return 8 * (i >> 2) + 4 * n + (i & 3); }
__device__ __forceinline__ unsigned cvt_pk_bf16(float lo, float hi) { return pk2(lo, hi); }

struct Unit { int pm, pn, e, j; };

struct DenseSched {
    static constexpr bool GATHER = false;
    const bf16* A; const bf16* Bt; int K, nM, nN, nwg, G, c;
    __device__ __forceinline__ void init(const bf16* A_, const bf16* Bt_, int M, int N, int K_, int G_, int c_) { A = A_; Bt = Bt_; K = K_; nM = M / BM; nN = N / BM; nwg = nM * nN; G = G_; c = c_; }
    __device__ __forceinline__ bool next(int i, Unit& u) const {
        const long L = (long)i * G + c; if (L >= nwg) return false;
        int wgid = (int)L; { const int q = nwg / NXCD, r = nwg % NXCD, xcd = wgid % NXCD, off = wgid / NXCD; wgid = (xcd < r ? xcd * (q + 1) : r * (q + 1) + (xcd - r) * q) + off; }
        const int nig = WGM * nN, gid = wgid / nig, fm = gid * WGM, gsz = (nM - fm) < WGM ? (nM - fm) : WGM;
        u.pm = fm + ((wgid % nig) % gsz); u.pn = (wgid % nig) / gsz; u.e = 0; u.j = 0; return true;
    }
    __device__ __forceinline__ const char* a_base(const Unit& u) const { return (const char*)A + (size_t)u.pm * BM * K * 2; }
    __device__ __forceinline__ const char* b_base(const Unit& u) const { return (const char*)Bt + (size_t)u.pn * BM * K * 2; }
    __device__ __forceinline__ void a_voff(const Unit&, unsigned (&)[2][2]) const {}
};
struct MoeGuSched {
    static constexpr bool GATHER = true;
    const bf16* A; const bf16* Bt; const int* list; MoeTab T; int K, G, c, nunits;
    __device__ __forceinline__ bool next(int i, Unit& u) const {
        const int L = i * G + c; if (L >= nunits) return false; u.pm = L >> 2; u.pn = L & 3; moe_find(T, u.pm, u.e, u.j); return true; }
    __device__ __forceinline__ const char* a_base(const Unit&) const { return (const char*)A; }
    __device__ __forceinline__ const char* b_base(const Unit& u) const { return (const char*)Bt + ((size_t)u.e * 1024 + u.pn * 256) * K * 2; }
    __device__ __forceinline__ void a_voff(const Unit& u, unsigned (&vo)[2][2]) const {
        const int cnt = T.cn[u.e];
        int tz = threadIdx.x; asm volatile("" : "+v"(tz));
#pragma unroll
        for (int i = 0; i < 2; ++i) { int R, C; stage_rc(tz * 16 + i * 8192, R, C);
#pragma unroll
            for (int h = 0; h < 2; ++h) { const int slot = u.j * 256 + h * 128 + R; const int pr = list[u.e * LISTCAP + slot]; const int pair = slot < cnt ? pr : 0; vo[h][i] = (unsigned)((pair >> 1) * K + C) * 2u; } }
    }
};
struct MoeDnSched {
    static constexpr bool GATHER = false;
    const bf16* A; const bf16* Bt; MoeTab T; int K, G, c, nunits;
    __device__ __forceinline__ bool next(int i, Unit& u) const {
        const int L = i * G + c; if (L >= nunits) return false; u.pm = L >> 2; u.pn = L & 3; moe_find(T, u.pm, u.e, u.j); return true; }
    __device__ __forceinline__ const char* a_base(const Unit& u) const { return (const char*)A + (size_t)u.pm * BM * K * 2; }
    __device__ __forceinline__ const char* b_base(const Unit& u) const { return (const char*)Bt + ((size_t)u.e * 1024 + u.pn * 256) * K * 2; }
    __device__ __forceinline__ void a_voff(const Unit&, unsigned (&)[2][2]) const {}
};

struct EpiBf16 {
    static constexpr bool PERM = true;
    bf16* O; int ldc; int split_cols; size_t split_stride;
    __device__ __forceinline__ void operator()(const f32x4 (&acc)[2][2][4][2], const Unit& u, int wr, int wc, int fr, int fq) const {
        const int row0 = u.pm * BM + wr * 64 + fr; int colt = u.pn * BM; bf16* base = O;
        if (split_cols) { const int t = colt / split_cols; base += (size_t)t * split_stride; colt -= t * split_cols; }
        const int col0 = colt + wc * 32 + 8 * fq;
#pragma unroll
        for (int ai = 0; ai < 2; ++ai)
#pragma unroll
            for (int m = 0; m < 4; ++m) { bf16* rowp = base + (size_t)(row0 + ai * HALF + m * 16) * ldc + col0;
#pragma unroll
                for (int bj = 0; bj < 2; ++bj) { const f32x4 v0 = acc[ai][bj][m][0], v1 = acc[ai][bj][m][1];
                    v4u w; w.x = cvt_pk_bf16(v0[0], v0[1]); w.y = cvt_pk_bf16(v0[2], v0[3]); w.z = cvt_pk_bf16(v1[0], v1[1]); w.w = cvt_pk_bf16(v1[2], v1[3]);
                    *(v4u*)(rowp + bj * HALF) = w; } }
    }
};
struct EpiResF32 {
    static constexpr bool PERM = false;
    float* C; const float* res; int ldc;
    __device__ __forceinline__ void operator()(const f32x4 (&acc)[2][2][4][2], const Unit& u, int wr, int wc, int fr, int fq) const {
        const int row0 = u.pm * BM + wr * 64 + fr, col0 = u.pn * BM + wc * 32 + 4 * fq;
#pragma unroll
        for (int ai = 0; ai < 2; ++ai)
#pragma unroll
            for (int m = 0; m < 4; ++m) { const size_t ro = (size_t)(row0 + ai * HALF + m * 16) * ldc + col0;
#pragma unroll
                for (int bj = 0; bj < 2; ++bj)
#pragma unroll
                    for (int n = 0; n < 2; ++n) { const f32x4 rv = *(const f32x4*)(res + ro + bj * HALF + n * 16); *(f32x4*)(C + ro + bj * HALF + n * 16) = rv * DN_ALPHA + acc[ai][bj][m][n]; } }
    }
};
struct EpiGateUp {
    static constexpr bool PERM = true;
    bf16* hid; const float* glist; MoeTab T;
    __device__ __forceinline__ void operator()(const f32x4 (&acc)[2][2][4][2], const Unit& u, int wr, int wc, int fr, int fq) const {
        const int cnt = T.cn[u.e];
        float gvv[2][4];
#pragma unroll
        for (int ai = 0; ai < 2; ++ai)
#pragma unroll
            for (int m = 0; m < 4; ++m) gvv[ai][m] = glist[u.e * LISTCAP + u.j * 256 + ai * HALF + wr * 64 + m * 16 + fr];
#pragma unroll
        for (int ai = 0; ai < 2; ++ai)
#pragma unroll
            for (int m = 0; m < 4; ++m) { const int r = ai * HALF + wr * 64 + m * 16 + fr, slot = u.j * 256 + r;
                const float gv = slot < cnt ? gvv[ai][m] : 0.f;
                float o[8];
#pragma unroll
                for (int n = 0; n < 2; ++n)
#pragma unroll
                    for (int q = 0; q < 4; ++q) { const float g = acc[ai][0][m][n][q], up = acc[ai][1][m][n][q]; o[n * 4 + q] = g / (1.0f + __expf(-g)) * up * gv; }
                v4u w; w.x = cvt_pk_bf16(o[0], o[1]); w.y = cvt_pk_bf16(o[2], o[3]); w.z = cvt_pk_bf16(o[4], o[5]); w.w = cvt_pk_bf16(o[6], o[7]);
                *(v4u*)(hid + ((size_t)u.pm * 256 + r) * FF + u.pn * 128 + wc * 32 + 8 * fq) = w; }
    }
};
struct EpiDown {
    static constexpr bool PERM = true;
    bf16* out2; const int* list; MoeTab T;
    __device__ __forceinline__ void operator()(const f32x4 (&acc)[2][2][4][2], const Unit& u, int wr, int wc, int fr, int fq) const {
        const int cnt = T.cn[u.e];
        int prr[2][4];
#pragma unroll
        for (int ai = 0; ai < 2; ++ai)
#pragma unroll
            for (int m = 0; m < 4; ++m) prr[ai][m] = list[u.e * LISTCAP + u.j * 256 + ai * HALF + wr * 64 + m * 16 + fr];
#pragma unroll
        for (int ai = 0; ai < 2; ++ai)
#pragma unroll
            for (int m = 0; m < 4; ++m) { const int r = ai * HALF + wr * 64 + m * 16 + fr, slot = u.j * 256 + r;
                if (slot < cnt) { const int pair = prr[ai][m]; bf16* rowp = out2 + (size_t)pair * DM + u.pn * 256 + wc * 32 + 8 * fq;
#pragma unroll
                    for (int bj = 0; bj < 2; ++bj) { const f32x4 v0 = acc[ai][bj][m][0], v1 = acc[ai][bj][m][1];
                        v4u w; w.x = cvt_pk_bf16(v0[0], v0[1]); w.y = cvt_pk_bf16(v0[2], v0[3]); w.z = cvt_pk_bf16(v1[0], v1[1]); w.w = cvt_pk_bf16(v1[2], v1[3]);
                        *(v4u*)(rowp + bj * HALF) = w; } } }
    }
};

template <class Epi, class Sched, bool ALIGN_EPI, bool SP2>
__device__ __forceinline__ void gemm_phase(LAS unsigned char* lds, const Sched& S, const Epi& E) {
    constexpr bool GATHER = Sched::GATHER;
    const int tid = threadIdx.x, wid = __builtin_amdgcn_readfirstlane(tid >> 6), lane = tid & 63, wr = wid >> 2, wc = wid & 3, fr = lane & 15, fq = lane >> 4;
    const int K = S.K, nt = K / BK;
    unsigned voffA[2], voffB[2];
#pragma unroll
    for (int i = 0; i < 2; ++i) { int R, C; stage_rc(tid * 16 + i * 8192, R, C); const int Rb = Epi::PERM ? ((R & ~31) + perm32(R & 31)) : R;
        voffA[i] = (unsigned)(R * K + C) * 2u; voffB[i] = (unsigned)(Rb * K + C) * 2u; }
    const size_t kstep = (size_t)(BK * 2);
    const size_t hstep = (size_t)HALF * K * 2;
    const size_t hstepA = GATHER ? 0 : hstep;
    const unsigned ldsw = (unsigned)wid * 1024u;
    const int aoff = lds_byte(wr * 64 + fr, fq * 8), boff = lds_byte(wc * 32 + fr, fq * 8);
#define PG8_SA(b, h) (((b) * 2 + (h)) * HTB)
#define PG8_SB(b, h) ((4 + (b) * 2 + (h)) * HTB)
#define PG8_STAGE2(bufoff, gbase, o0, o1) do { \
        __builtin_amdgcn_global_load_lds((const unsigned*)((const char*)(gbase) + (o0)), (LAS unsigned*)(lds + (bufoff) + ldsw), 16, 0, 0); \
        __builtin_amdgcn_global_load_lds((const unsigned*)((const char*)(gbase) + (o1)), (LAS unsigned*)(lds + (bufoff) + ldsw + 8192), 16, 0, 0); } while (0)
#define PG8_STAGEB(bufoff, gbase) PG8_STAGE2(bufoff, gbase, voffB[0], voffB[1])
#define PG8_LDA(dst, b, h) do { _Pragma("unroll") for (int m = 0; m < 4; ++m) _Pragma("unroll") for (int k = 0; k < 2; ++k) dst[m][k] = *(const LAS bf16x8*)(lds + PG8_SA(b, h) + aoff + m * 2048 + k * 1024); } while (0)
#define PG8_LDB(dst, b, h) do { _Pragma("unroll") for (int n = 0; n < 2; ++n) _Pragma("unroll") for (int k = 0; k < 2; ++k) dst[n][k] = *(const LAS bf16x8*)(lds + PG8_SB(b, h) + boff + n * 2048 + k * 1024); } while (0)
#define PG8_MMA(ai, bj, At, Bt) do { __builtin_amdgcn_s_setprio(1); _Pragma("unroll") for (int m = 0; m < 4; ++m) _Pragma("unroll") for (int n = 0; n < 2; ++n) _Pragma("unroll") for (int k = 0; k < 2; ++k) \
        acc[ai][bj][m][n] = __builtin_amdgcn_mfma_f32_16x16x32_bf16(Bt[n][k], At[m][k], acc[ai][bj][m][n], 0, 0, 0); __builtin_amdgcn_s_setprio(0); } while (0)
#define PG8_WAIT_V(n) asm volatile("s_waitcnt vmcnt(" #n ")" ::: "memory")
#define PG8_WAIT_L(n) asm volatile("s_waitcnt lgkmcnt(" #n ")" ::: "memory")
#define PG8_BAR __builtin_amdgcn_s_barrier()
#define PG8_SCHED __builtin_amdgcn_sched_barrier(0)
    volatile LAS unsigned long long* gsub = (volatile LAS unsigned long long*)(lds + MISC_OFF + 1536);
#define GSTAMP() do { if ((PROBE_A >= 100 || PROBE_B >= 100) && blockIdx.x == 0 && threadIdx.x == 0 && gsub[31] != 0ull) { const unsigned long long n_ = gsub[30]; if (n_ < 14ull) { gsub[12 + n_] = wall_clock64(); gsub[30] = n_ + 1ull; } } } while (0)
    Unit cur, nxt; int ui = 0;
    if (!S.next(0, cur)) return;
    GSTAMP();
    f32x4 acc[2][2][4][2];
#pragma unroll
    for (int a = 0; a < 2; ++a)
#pragma unroll
        for (int b = 0; b < 2; ++b)
#pragma unroll
            for (int m = 0; m < 4; ++m)
#pragma unroll
                for (int n = 0; n < 2; ++n) acc[a][b][m][n] = (f32x4){0.f, 0.f, 0.f, 0.f};
    bf16x8 At[4][2], B0[2][2], B1[2][2];
    unsigned cvo[2][2];
    if constexpr (GATHER) S.a_voff(cur, cvo); else { cvo[0][0] = cvo[1][0] = voffA[0]; cvo[0][1] = cvo[1][1] = voffA[1]; }
    const char* cA = S.a_base(cur); const char* cB = S.b_base(cur);
    if constexpr (SP2) {
        PG8_STAGEB(PG8_SB(0, 0), cB); PG8_STAGEB(PG8_SB(0, 1), cB + hstep); PG8_STAGE2(PG8_SA(0, 0), cA, cvo[0][0], cvo[0][1]); PG8_STAGE2(PG8_SA(0, 1), cA + hstepA, cvo[1][0], cvo[1][1]);
        if (wr == 1) PG8_BAR;
        PG8_WAIT_V(2); PG8_BAR;
        PG8_STAGEB(PG8_SB(1, 0), cB + kstep); PG8_STAGE2(PG8_SA(1, 0), cA + kstep, cvo[0][0], cvo[0][1]); PG8_STAGEB(PG8_SB(1, 1), cB + hstep + kstep);
        PG8_WAIT_V(6); PG8_BAR;
    } else {
        PG8_STAGEB(PG8_SB(0, 0), cB); PG8_STAGE2(PG8_SA(0, 0), cA, cvo[0][0], cvo[0][1]); PG8_STAGEB(PG8_SB(0, 1), cB + hstep); PG8_STAGE2(PG8_SA(0, 1), cA + hstepA, cvo[1][0], cvo[1][1]);
        if (wr == 1) PG8_BAR;
        PG8_WAIT_V(4); PG8_BAR;
        PG8_STAGEB(PG8_SB(1, 0), cB + kstep); PG8_STAGE2(PG8_SA(1, 0), cA + kstep, cvo[0][0], cvo[0][1]); PG8_STAGEB(PG8_SB(1, 1), cB + hstep + kstep);
        PG8_WAIT_V(6); PG8_BAR;
    }
    for (;;) {
        const bool has_next = S.next(ui + 1, nxt);
        const char* nA = has_next ? S.a_base(nxt) : cA; const char* nB = has_next ? S.b_base(nxt) : cB;
        for (int t = 0; t < nt; t += 2) {
            const bool last = (t == nt - 2);
            const char* a1 = cA + (size_t)(t + 1) * kstep;
            const char* a2 = last ? nA : cA + (size_t)(t + 2) * kstep; const char* b2 = last ? nB : cB + (size_t)(t + 2) * kstep;
            const char* a3 = a2 + kstep; const char* b3 = b2 + kstep;
            if constexpr (SP2) {
            PG8_LDB(B0, 0, 0); PG8_LDB(B1, 0, 1); PG8_SCHED; PG8_LDA(At, 0, 0); PG8_STAGE2(PG8_SA(1, 1), a1 + hstepA, cvo[1][0], cvo[1][1]);
            if constexpr (GATHER) { if (last && has_next) S.a_voff(nxt, cvo); }
            PG8_WAIT_V(8); PG8_WAIT_L(0); PG8_BAR; PG8_MMA(0, 0, At, B0); PG8_MMA(0, 1, At, B1); PG8_BAR; PG8_SCHED;
            PG8_LDA(At, 0, 1); PG8_STAGEB(PG8_SB(0, 0), b2); PG8_STAGEB(PG8_SB(0, 1), b2 + hstep); PG8_STAGE2(PG8_SA(0, 0), a2, cvo[0][0], cvo[0][1]);
            PG8_WAIT_V(8); PG8_WAIT_L(0); PG8_BAR; PG8_MMA(1, 0, At, B0); PG8_MMA(1, 1, At, B1); PG8_BAR; PG8_SCHED;
            PG8_LDB(B0, 1, 0); PG8_LDB(B1, 1, 1); PG8_SCHED; PG8_LDA(At, 1, 0); PG8_STAGE2(PG8_SA(0, 1), a2 + hstepA, cvo[1][0], cvo[1][1]);
            PG8_WAIT_V(8); PG8_WAIT_L(0); PG8_BAR; PG8_MMA(0, 0, At, B0); PG8_MMA(0, 1, At, B1); PG8_BAR; PG8_SCHED;
            PG8_LDA(At, 1, 1); PG8_STAGEB(PG8_SB(1, 0), b3); PG8_STAGEB(PG8_SB(1, 1), b3 + hstep); PG8_STAGE2(PG8_SA(1, 0), a3, cvo[0][0], cvo[0][1]);
            PG8_WAIT_V(8); PG8_WAIT_L(0); PG8_BAR; PG8_MMA(1, 0, At, B0); PG8_MMA(1, 1, At, B1); PG8_BAR; PG8_SCHED;
            } else {
            PG8_LDB(B0, 0, 0); PG8_SCHED; PG8_LDA(At, 0, 0); PG8_STAGE2(PG8_SA(1, 1), a1 + hstepA, cvo[1][0], cvo[1][1]);
            if constexpr (GATHER) { if (last && has_next) S.a_voff(nxt, cvo); }
            PG8_WAIT_L(8); PG8_BAR; PG8_WAIT_L(0); PG8_MMA(0, 0, At, B0); PG8_BAR; PG8_SCHED;
            PG8_LDB(B1, 0, 1); PG8_STAGEB(PG8_SB(0, 0), b2);
            PG8_BAR; PG8_WAIT_L(0); PG8_MMA(0, 1, At, B1); PG8_BAR;
            PG8_LDA(At, 0, 1); PG8_STAGE2(PG8_SA(0, 0), a2, cvo[0][0], cvo[0][1]);
            PG8_BAR; PG8_WAIT_L(0); PG8_MMA(1, 0, At, B0); PG8_BAR; PG8_SCHED;
            PG8_STAGEB(PG8_SB(0, 1), b2 + hstep);
            PG8_WAIT_V(6); PG8_BAR; PG8_MMA(1, 1, At, B1); PG8_BAR;
            PG8_LDB(B0, 1, 0); PG8_SCHED; PG8_LDA(At, 1, 0); PG8_STAGE2(PG8_SA(0, 1), a2 + hstepA, cvo[1][0], cvo[1][1]);
            PG8_WAIT_L(8); PG8_BAR; PG8_WAIT_L(0); PG8_MMA(0, 0, At, B0); PG8_BAR; PG8_SCHED;
            PG8_LDB(B1, 1, 1); PG8_STAGEB(PG8_SB(1, 0), b3);
            PG8_BAR; PG8_WAIT_L(0); PG8_MMA(0, 1, At, B1); PG8_BAR;
            PG8_LDA(At, 1, 1); PG8_STAGE2(PG8_SA(1, 0), a3, cvo[0][0], cvo[0][1]);
            PG8_BAR; PG8_WAIT_L(0); PG8_MMA(1, 0, At, B0); PG8_BAR; PG8_SCHED;
            PG8_STAGEB(PG8_SB(1, 1), b3 + hstep);
            PG8_WAIT_V(6); PG8_BAR; PG8_MMA(1, 1, At, B1); PG8_BAR;
            }
        }
        GSTAMP();
        if constexpr (ALIGN_EPI) { if (wr == 0) PG8_BAR; }
        E(acc, cur, wr, wc, fr, fq);
        GSTAMP();
        if (!has_next) break;
#pragma unroll
        for (int a = 0; a < 2; ++a)
#pragma unroll
            for (int b = 0; b < 2; ++b)
#pragma unroll
                for (int m = 0; m < 4; ++m)
#pragma unroll
                    for (int n = 0; n < 2; ++n) acc[a][b][m][n] = (f32x4){0.f, 0.f, 0.f, 0.f};
        cur = nxt; cA = nA; cB = nB; ++ui;
        if constexpr (ALIGN_EPI) { if (wr == 1) PG8_BAR; }
    }
    PG8_WAIT_V(0);
    if constexpr (!ALIGN_EPI) { if (wr == 0) PG8_BAR; }
    PG8_BAR;
    GSTAMP();
#undef GSTAMP
#undef PG8_SA
#undef PG8_SB
#undef PG8_STAGE2
#undef PG8_STAGEB
#undef PG8_LDA
#undef PG8_LDB
#undef PG8_MMA
#undef PG8_WAIT_V
#undef PG8_WAIT_L
#undef PG8_BAR
#undef PG8_SCHED
}
}

template <int NB>
__device__ __forceinline__ void thin_kloop(const bf16* ap, const bf16* const (&bp)[NB], int K, int koff, f32x4 (&acc)[NB]) {
    for (int k0 = 0; k0 < K; k0 += 256) {
        bf16x8 af[8], bfr[NB][8];
#pragma unroll
        for (int q = 0; q < 8; ++q) { af[q] = *(const bf16x8*)(ap + k0 + 32 * q + koff);
#pragma unroll
            for (int nb = 0; nb < NB; ++nb) bfr[nb][q] = *(const bf16x8*)(bp[nb] + k0 + 32 * q + koff); }
#pragma unroll
        for (int q = 0; q < 8; ++q)
#pragma unroll
            for (int nb = 0; nb < NB; ++nb) acc[nb] = __builtin_amdgcn_mfma_f32_16x16x32_bf16(af[q], bfr[nb][q], acc[nb], 0, 0, 0);
    }
}
__device__ __forceinline__ void fast_moe_gateup(Frame& F, int layer) {
    volatile LAS unsigned long long* subL = (volatile LAS unsigned long long*)(F.lds + MISC_OFF + 1536);
#define SUBSTAMP2(k) do { if ((PROBE_A >= 100 || PROBE_B >= 100) && F.bid == 0 && threadIdx.x == 0 && layer == 0) subL[k] = wall_clock64(); } while (0)
    SUBSTAMP2(8);
    const MoeTab T = moe_table(F, layer, true);
    SUBSTAMP2(9);
    if ((PROBE_A >= 100 || PROBE_B >= 100) && F.bid == 0 && threadIdx.x == 0) { subL[30] = 0ull; subL[31] = (layer == 0) ? 1ull : 0ull; }
    { pg8::MoeGuSched S; S.A = WSP(bf16, WS_HB); S.Bt = WSP(bf16, layer ? WS_GU1 : WS_GU0); S.list = WSP(int, WS_LIST); S.T = T; S.K = DM; S.G = F.G; S.c = F.bid; S.nunits = T.ts[NEXP] * 4;
      pg8::EpiGateUp E{WSP(bf16, WS_HID), WSP(float, WS_GLIST), T};
      pg8::gemm_phase<pg8::EpiGateUp, pg8::MoeGuSched, true, true>(F.lds, S, E); }
    SUBSTAMP2(10);
    if ((PROBE_A >= 100 || PROBE_B >= 100) && F.bid == 0 && threadIdx.x == 0) subL[31] = 0ull;
    const bf16* hb = WSP(bf16, WS_HB); const bf16* gu = WSP(bf16, layer ? WS_GU1 : WS_GU0); bf16* hid = WSP(bf16, WS_HID);
    const int* list = WSP(int, WS_LIST); const float* glist = WSP(float, WS_GLIST);
    int tz = threadIdx.x; asm volatile("" : "+v"(tz));
    const int lane = tz & 63, l15 = lane & 15, g4 = lane >> 4, w = F.wave, rbk = w & 3, fh = w >> 2, ntu = T.nth[0] * 16;
    for (int tu = (F.bid + F.G - (T.ts[NEXP] * 4) % F.G) % F.G; tu < ntu; tu += F.G) {
        const int e = T.tl[tu >> 4], sl = tu & 15, c = T.cn[e], s0 = T.ths[e];
        const int slot = s0 + rbk * 16 + l15, pair = slot < c ? list[e * LISTCAP + slot] : 0, f0 = sl * 32 + fh * 16;
        const bf16* ap = hb + (size_t)(pair >> 1) * DM;
        const bf16* bp[2]; bp[0] = gu + ((size_t)e * 1024 + (f0 >> 7) * 256 + (f0 & 127) + l15) * DM; bp[1] = bp[0] + (size_t)128 * DM;
        f32x4 acc[2] = {(f32x4){0.f, 0.f, 0.f, 0.f}, (f32x4){0.f, 0.f, 0.f, 0.f}};
        thin_kloop<2>(ap, bp, DM, 8 * g4, acc);
#pragma unroll
        for (int q = 0; q < 4; ++q) { const int r = rbk * 16 + g4 * 4 + q, sr = s0 + r;
            if (sr < c) { const float gv = glist[e * LISTCAP + sr], g = acc[0][q]; hid[(size_t)(T.tho[e] + r) * FF + f0 + l15] = (bf16)f2bf(g / (1.0f + __expf(-g)) * acc[1][q] * gv); } }
    }
    SUBSTAMP2(11);
}
__device__ __forceinline__ void fast_moe_down(Frame& F, int layer) {
    const MoeTab T = moe_table(F, layer, true);
    { pg8::MoeDnSched S; S.A = WSP(bf16, WS_HID); S.Bt = WSP(bf16, layer ? WS_DN1 : WS_DN0); S.T = T; S.K = FF; S.G = F.G; S.c = F.bid; S.nunits = T.ts[NEXP] * 4;
      pg8::EpiDown E{WSP(bf16, WS_OUT2), WSP(int, WS_LIST), T};
      pg8::gemm_phase<pg8::EpiDown, pg8::MoeDnSched, true, true>(F.lds, S, E); }
    const bf16* hid = WSP(bf16, WS_HID); const bf16* dn = WSP(bf16, layer ? WS_DN1 : WS_DN0); bf16* out2 = WSP(bf16, WS_OUT2);
    const int* list = WSP(int, WS_LIST);
    int tz = threadIdx.x; asm volatile("" : "+v"(tz));
    const int lane = tz & 63, l15 = lane & 15, g4 = lane >> 4, w = F.wave, rbk = w & 3, chh = w >> 2, ntu = T.nth[0] * 16;
    for (int tu = (F.bid + F.G - (T.ts[NEXP] * 4) % F.G) % F.G; tu < ntu; tu += F.G) {
        const int e = T.tl[tu >> 4], sl = tu & 15, c = T.cn[e], s0 = T.ths[e], nr = c - s0;
        const int row = rbk * 16 + l15, c0 = sl * 64 + chh * 32;
        const bf16* ap = hid + (size_t)(T.tho[e] + (row < nr ? row : 0)) * FF;
        const bf16* bp[2]; bp[0] = dn + ((size_t)e * DM + c0 + l15) * FF; bp[1] = bp[0] + (size_t)16 * FF;
        f32x4 acc[2] = {(f32x4){0.f, 0.f, 0.f, 0.f}, (f32x4){0.f, 0.f, 0.f, 0.f}};
        thin_kloop<2>(ap, bp, FF, 8 * g4, acc);
#pragma unroll
        for (int q = 0; q < 4; ++q) { const int r = rbk * 16 + g4 * 4 + q;
            if (r < nr) { const int pair = list[e * LISTCAP + s0 + r]; out2[(size_t)pair * DM + c0 + l15] = (bf16)f2bf(acc[0][q]); out2[(size_t)pair * DM + c0 + 16 + l15] = (bf16)f2bf(acc[1][q]); } }
    }
}
__device__ __forceinline__ void fast_inproj_dt(Frame& F) {
    const bf16* xb = WSP(bf16, WS_XB); const bf16* wt = WSP(bf16, WS_INWT); bf16* zx = WSP(bf16, WS_ZX);
    int tz = threadIdx.x; asm volatile("" : "+v"(tz));
    const int lane = tz & 63, l15 = lane & 15, g4 = lane >> 4, w = F.wave, rbk = w & 3, cb = w >> 2;
    for (int tu = F.bid; tu < MTOK / 64; tu += F.G) {
        const bf16* ap = xb + (size_t)(tu * 64 + rbk * 16 + l15) * DM;
        const bf16* bp[1]; bp[0] = wt + (size_t)(ZX_DT + cb * 16 + l15) * DM;
        f32x4 acc[1] = {(f32x4){0.f, 0.f, 0.f, 0.f}};
        thin_kloop<1>(ap, bp, DM, 8 * g4, acc);
#pragma unroll
        for (int q = 0; q < 4; ++q) zx[(size_t)(tu * 64 + rbk * 16 + g4 * 4 + q) * LDZ + ZX_DT + cb * 16 + l15] = (bf16)f2bf(acc[0][q]);
    }
}

constexpr int ATT_KS = 72, ATT_VS = 264;
__device__ __forceinline__ void fast_attention(Frame& F) {
    const bf16* Q = WSP(bf16, WS_Q); const bf16* Kb = WSP(bf16, WS_K); const bf16* Vb = WSP(bf16, WS_V); bf16* O = WSP(bf16, WS_O); float* lse = WSP(float, WS_LSE);
    const float* relb = F.in[12];
    LAS bf16* Ks = (LAS bf16*)F.lds; LAS bf16* VT = (LAS bf16*)(F.lds + 256 * ATT_KS * 2); LAS float* biasv = (LAS float*)(F.lds + 256 * ATT_KS * 2 + 64 * ATT_VS * 2);
    const int lane = F.lane, w = F.wave, l15 = lane & 15, g4 = lane >> 4, wlo = w < 6 ? w : 6;
    for (int u = F.bid; u < BATCH * AH * 16; u += F.G) {
        const int x = u & 15, hd = (u >> 4) & 15, b = u >> 8;
        const int dil = hd < 6 ? 1 : (hd < 11 ? 4 : 16), nb = 16 / dil, n = x % nb, r = x / nb;
        const size_t rowb = (size_t)b * SEQ;
        __syncthreads();
#pragma unroll
        for (int c = 0; c < 4; ++c) {
            const int ch = F.tid + 512 * c, kk = ch >> 3, part = ch & 7, jk = n * 128 - 128 + kk;
            v4u kv = (v4u){0u, 0u, 0u, 0u}, vv = (v4u){0u, 0u, 0u, 0u};
            if (jk >= 0) { const size_t off = (rowb + (size_t)jk * dil + r) * DM + hd * AD + part * 8; kv = *(const v4u*)(Kb + off); vv = *(const v4u*)(Vb + off); }
            *(LAS v4u*)(Ks + kk * ATT_KS + part * 8) = kv;
#pragma unroll
            for (int e = 0; e < 4; ++e) { VT[(part * 8 + 2 * e) * ATT_VS + kk] = (bf16)(vv[e] & 0xffffu); VT[(part * 8 + 2 * e + 1) * ATT_VS + kk] = (bf16)(vv[e] >> 16); }
        }
        if (F.tid <= 128) biasv[F.tid] = relb[t5_bucket(F.tid * dil) * AH + hd];
        const int qi = 16 * w + l15;
        const size_t qrow = rowb + (size_t)(n * 128 + qi) * dil + r;
        bf16x8 qf[2];
#pragma unroll
        for (int ks = 0; ks < 2; ++ks) qf[ks] = *(const bf16x8*)(Q + qrow * DM + hd * AD + 32 * ks + 8 * g4);
        __syncthreads();
        f32x4 sacc[10];
#pragma unroll
        for (int bi = 0; bi < 10; ++bi) { sacc[bi] = (f32x4){0.f, 0.f, 0.f, 0.f};
#pragma unroll
            for (int ks = 0; ks < 2; ++ks) { const bf16x8 kf = *(const LAS bf16x8*)(Ks + ((wlo + bi) * 16 + l15) * ATT_KS + 32 * ks + 8 * g4);
                sacc[bi] = __builtin_amdgcn_mfma_f32_16x16x32_bf16(kf, qf[ks], sacc[bi], 0, 0, 0); } }
        float mx = -INFINITY;
#pragma unroll
        for (int bi = 0; bi < 10; ++bi)
#pragma unroll
            for (int q = 0; q < 4; ++q) { const int kk = (wlo + bi) * 16 + g4 * 4 + q, delta = qi + 128 - kk; const bool ok = delta >= 0 && delta <= 128 && (n * 128 - 128 + kk) >= 0;
                const float sv = ok ? sacc[bi][q] * 0.125f + biasv[ok ? delta : 0] : -INFINITY; sacc[bi][q] = sv; mx = fmaxf(mx, sv); }
        mx = fmaxf(mx, __shfl_xor(mx, 16)); mx = fmaxf(mx, __shfl_xor(mx, 32));
        float den = 0.f;
#pragma unroll
        for (int bi = 0; bi < 10; ++bi)
#pragma unroll
            for (int q = 0; q < 4; ++q) { const float pv = __expf(sacc[bi][q] - mx); sacc[bi][q] = pv; den += pv; }
        den += __shfl_xor(den, 16); den += __shfl_xor(den, 32);
        f32x4 oacc[4];
#pragma unroll
        for (int db = 0; db < 4; ++db) oacc[db] = (f32x4){0.f, 0.f, 0.f, 0.f};
#pragma unroll
        for (int k2 = 0; k2 < 5; ++k2) {
            union { bf16x8 v; unsigned u[4]; } pf;
            pf.u[0] = pk2(sacc[2 * k2][0], sacc[2 * k2][1]); pf.u[1] = pk2(sacc[2 * k2][2], sacc[2 * k2][3]);
            pf.u[2] = pk2(sacc[2 * k2 + 1][0], sacc[2 * k2 + 1][1]); pf.u[3] = pk2(sacc[2 * k2 + 1][2], sacc[2 * k2 + 1][3]);
#pragma unroll
            for (int db = 0; db < 4; ++db) {
                union { bf16x8 v; v2u h[2]; } vf;
                const LAS bf16* vp = VT + (db * 16 + l15) * ATT_VS + (wlo + 2 * k2) * 16 + g4 * 4;
                vf.h[0] = *(const LAS v2u*)vp; vf.h[1] = *(const LAS v2u*)(vp + 16);
                oacc[db] = __builtin_amdgcn_mfma_f32_16x16x32_bf16(vf.v, pf.v, oacc[db], 0, 0, 0);
            }
        }
        const float inv = 1.0f / den;
#pragma unroll
        for (int db = 0; db < 4; ++db) { const v2u o2 = (v2u){pk2(oacc[db][0] * inv, oacc[db][1] * inv), pk2(oacc[db][2] * inv, oacc[db][3] * inv)};
            *(v2u*)(O + qrow * DM + hd * AD + db * 16 + g4 * 4) = o2; }
        if (g4 == 0) lse[qrow * AH + hd] = mx + __logf(den);
    }
}

typedef float f32x16 __attribute__((ext_vector_type(16)));
typedef float f32x2 __attribute__((ext_vector_type(2)));
constexpr int SSD_LS = 136;
__device__ __forceinline__ void load_raw(const bf16* zx, size_t row0, int t0, bool first_chunk, int col0, v4u (&raw)[11]) {
#pragma unroll
    for (int i = 0; i < 11; ++i) { const int t = t0 - 3 + i; raw[i] = (v4u){0u, 0u, 0u, 0u};
        if (t >= 0 || !first_chunk) raw[i] = *(const v4u*)(zx + (size_t)((long)row0 + t) * LDZ + col0); }
}
__device__ __forceinline__ void conv_from_raw(const v4u (&raw)[11], const float* cw, const float* cbias, int ch0, float (&out)[8][8]) {
#pragma unroll
    for (int jp = 0; jp < 4; ++jp) {
        f32x2 wk[4];
#pragma unroll
        for (int k = 0; k < 4; ++k) wk[k] = *(const f32x2*)(cw + k * CONVD + ch0 + 2 * jp);
        const f32x2 bb = *(const f32x2*)(cbias + ch0 + 2 * jp);
#pragma unroll
        for (int r = 0; r < 8; ++r) { float lo = bb.x, hi = bb.y;
#pragma unroll
            for (int k = 0; k < 4; ++k) { lo += wk[k].x * bflo(raw[r + k][jp]); hi += wk[k].y * bfhi(raw[r + k][jp]); }
            out[r][2 * jp] = silu_f(lo); out[r][2 * jp + 1] = silu_f(hi); }
    }
}
__device__ __forceinline__ void ssd_dt_acs(Frame& F, float raw0, float raw1, int h, float& dt0, float& dt1, float& acs0, float& acs1, float& total) {
    const float dtb = F.in[4][h], Acoef = -__expf(F.in[5][h]);
    dt0 = softplus_f(raw0 + dtb); dt1 = softplus_f(raw1 + dtb);
    const float a0 = dt0 * Acoef, a1 = dt1 * Acoef; float v = a0 + a1;
#pragma unroll
    for (int o = 1; o < 64; o <<= 1) { const float t = __shfl_up(v, o); if (F.lane >= o) v += t; }
    acs1 = v; acs0 = v - a1; total = __shfl(v, 63);
}
__device__ __forceinline__ void fast_ssd_states_phase(Frame& F) {
    const bf16* zx = WSP(bf16, WS_ZX); bf16* stg = WSP(bf16, WS_ST);
    LAS bf16* BT = (LAS bf16*)F.lds; LAS bf16* XT = (LAS bf16*)(F.lds + 34816); LAS float* sL = (LAS float*)(F.lds + 34816 + 69632);
    const int w = F.wave;
#define SSD_IDS() int tz_ = threadIdx.x; asm volatile("" : "+v"(tz_)); const int lane = tz_ & 63, l31 = lane & 31, h5 = lane >> 5, cgx = tz_ & 31, rbx = tz_ >> 5, cgb = tz_ & 15, rbb = (tz_ >> 4) & 15; (void)l31; (void)h5; (void)cgx; (void)rbx; (void)cgb; (void)rbb; (void)lane
    for (int u = F.bid; u < BATCH * NCHK * NGRP; u += F.G) {
        const int b = u / (NCHK * NGRP), c = (u / NGRP) % NCHK, g = u % NGRP;
        const size_t row0 = (size_t)b * SEQ + (size_t)c * CHK;
        v4u rawx[11];
        { SSD_IDS(); v4u rawb[11];
          load_raw(zx, row0, rbb * 8, c == 0, ZX_B + g * 128 + cgb * 8, rawb); load_raw(zx, row0, rbx * 8, c == 0, ZX_X + g * 512 + cgx * 8, rawx);
          const float dr0 = bf2f(zx[(row0 + 2 * lane) * LDZ + ZX_DT + g * 8 + w]), dr1 = bf2f(zx[(row0 + 2 * lane + 1) * LDZ + ZX_DT + g * 8 + w]);
          __syncthreads();
          { float dt0, dt1, acs0, acs1, total; ssd_dt_acs(F, dr0, dr1, g * 8 + w, dt0, dt1, acs0, acs1, total);
            sL[w * 128 + 2 * lane] = dt0 * __expf(total - acs0); sL[w * 128 + 2 * lane + 1] = dt1 * __expf(total - acs1);
            if (lane == 0) WSP(float, WS_CD)[(b * NCHK + c) * NH + g * 8 + w] = __expf(total); }
          if (tz_ < 256) { float o[8][8];
            conv_from_raw(rawb, F.in[2], F.in[3], 2048 + g * 128 + cgb * 8, o);
#pragma unroll
            for (int e = 0; e < 8; ++e) *(LAS v4u*)(BT + (cgb * 8 + e) * SSD_LS + rbb * 8) = (v4u){pk2(o[0][e], o[1][e]), pk2(o[2][e], o[3][e]), pk2(o[4][e], o[5][e]), pk2(o[6][e], o[7][e])}; } }
        for (int hh = 0; hh < 2; ++hh) {
            __syncthreads();
            { SSD_IDS(); const int hl = cgx >> 3, xch = (g * 8 + hh * 4) * 64 + cgx * 8; float o[8][8];
              conv_from_raw(rawx, F.in[2], F.in[3], xch, o);
              float sc[8];
#pragma unroll
              for (int r = 0; r < 8; ++r) sc[r] = sL[(hh * 4 + hl) * 128 + rbx * 8 + r];
#pragma unroll
              for (int e = 0; e < 8; ++e) *(LAS v4u*)(XT + (cgx * 8 + e) * SSD_LS + rbx * 8) = (v4u){pk2(o[0][e] * sc[0], o[1][e] * sc[1]), pk2(o[2][e] * sc[2], o[3][e] * sc[3]), pk2(o[4][e] * sc[4], o[5][e] * sc[5]), pk2(o[6][e] * sc[6], o[7][e] * sc[7])};
              if (hh == 0) load_raw(zx, row0, rbx * 8, c == 0, ZX_X + g * 512 + 256 + cgx * 8, rawx); }
            __syncthreads();
            SSD_IDS();
            const int hl = w >> 1, pb = w & 1;
            f32x16 acc[4];
#pragma unroll
            for (int nb = 0; nb < 4; ++nb)
#pragma unroll
                for (int q = 0; q < 16; ++q) acc[nb][q] = 0.f;
#pragma unroll
            for (int ks = 0; ks < 8; ++ks) { const bf16x8 xf = *(const LAS bf16x8*)(XT + (hl * 64 + pb * 32 + l31) * SSD_LS + 16 * ks + 8 * h5);
#pragma unroll
                for (int nb = 0; nb < 4; ++nb) { const bf16x8 bfr = *(const LAS bf16x8*)(BT + (nb * 32 + l31) * SSD_LS + 16 * ks + 8 * h5); acc[nb] = __builtin_amdgcn_mfma_f32_32x32x16_bf16(bfr, xf, acc[nb], 0, 0, 0); } }
            const int h = g * 8 + hh * 4 + hl, p = pb * 32 + l31;
            bf16* sp = stg + ((size_t)((b * NCHK + c) * NH + h) * HD + p) * NST;
#pragma unroll
            for (int nb = 0; nb < 4; ++nb)
#pragma unroll
                for (int rg = 0; rg < 4; ++rg) *(v2u*)(sp + nb * 32 + 8 * rg + 4 * h5) = (v2u){pk2(acc[nb][4 * rg], acc[nb][4 * rg + 1]), pk2(acc[nb][4 * rg + 2], acc[nb][4 * rg + 3])};
        }
    }
}
#undef SSD_IDS
__device__ __forceinline__ void fast_ssd_out_phase(Frame& F) {
    const bf16* zx = WSP(bf16, WS_ZX); const bf16* prev = WSP(bf16, WS_ST); bf16* yn = (bf16*)F.out;
    LAS bf16* Bn = (LAS bf16*)F.lds; LAS bf16* Cn = (LAS bf16*)(F.lds + 34816); LAS bf16* XT = (LAS bf16*)(F.lds + 69632);
    LAS float* acsL = (LAS float*)(F.lds + 139264); LAS float* ldaL = acsL + 1024; LAS float* ssL = ldaL + 1024;
    const int w = F.wave;
    const float* nw = F.in[7];
    volatile LAS unsigned long long* subL = (volatile LAS unsigned long long*)(F.lds + MISC_OFF + 1536);
#define SUBSTAMP(k) do { if ((PROBE_A >= 100 || PROBE_B >= 100) && F.bid == 0 && threadIdx.x == 0 && u == F.bid) subL[k] = wall_clock64(); } while (0)
#define SSD_IDS() int tz_ = threadIdx.x; asm volatile("" : "+v"(tz_)); const int lane = tz_ & 63, l31 = lane & 31, h5 = lane >> 5, cgx = tz_ & 31, rbx = tz_ >> 5, which = tz_ >> 8, cgb = tz_ & 15, rbb = (tz_ >> 4) & 15; (void)l31; (void)h5; (void)cgx; (void)rbx; (void)which; (void)cgb; (void)rbb
    for (int u = F.bid; u < BATCH * NCHK * NGRP; u += F.G) {
        const int b = u / (NCHK * NGRP), c = (u / NGRP) % NCHK, g = u % NGRP;
        const size_t row0 = (size_t)b * SEQ + (size_t)c * CHK;
        SUBSTAMP(0);
        v4u rawx[11];
        { SSD_IDS(); v4u rawb[11];
          load_raw(zx, row0, rbb * 8, c == 0, (which ? ZX_C : ZX_B) + g * 128 + cgb * 8, rawb); load_raw(zx, row0, rbx * 8, c == 0, ZX_X + g * 512 + cgx * 8, rawx);
          const float dr0 = bf2f(zx[(row0 + 2 * lane) * LDZ + ZX_DT + g * 8 + w]), dr1 = bf2f(zx[(row0 + 2 * lane + 1) * LDZ + ZX_DT + g * 8 + w]);
          __syncthreads();
          { float dt0, dt1, acs0, acs1, total; ssd_dt_acs(F, dr0, dr1, g * 8 + w, dt0, dt1, acs0, acs1, total);
            acsL[w * 128 + 2 * lane] = acs0; acsL[w * 128 + 2 * lane + 1] = acs1; ldaL[w * 128 + 2 * lane] = __logf(dt0) - acs0; ldaL[w * 128 + 2 * lane + 1] = __logf(dt1) - acs1; }
          float o[8][8];
          conv_from_raw(rawb, F.in[2], F.in[3], 2048 + which * 512 + g * 128 + cgb * 8, o);
          LAS bf16* dst = (which ? Cn : Bn) + (rbb * 8) * SSD_LS + cgb * 8;
#pragma unroll
          for (int r = 0; r < 8; ++r) *(LAS v4u*)(dst + r * SSD_LS) = (v4u){pk2(o[r][0], o[r][1]), pk2(o[r][2], o[r][3]), pk2(o[r][4], o[r][5]), pk2(o[r][6], o[r][7])}; }
        SUBSTAMP(1);
        for (int hh = 0; hh < 2; ++hh) {
            if (hh == 1) __syncthreads();
            { SSD_IDS(); const int xch = (g * 8 + hh * 4) * 64 + cgx * 8; float o[8][8];
              conv_from_raw(rawx, F.in[2], F.in[3], xch, o);
#pragma unroll
              for (int e = 0; e < 8; ++e) *(LAS v4u*)(XT + (cgx * 8 + e) * SSD_LS + rbx * 8) = (v4u){pk2(o[0][e], o[1][e]), pk2(o[2][e], o[3][e]), pk2(o[4][e], o[5][e]), pk2(o[6][e], o[7][e])};
              if (hh == 0) load_raw(zx, row0, rbx * 8, c == 0, ZX_X + g * 512 + 256 + cgx * 8, rawx); }
            __syncthreads();
            SUBSTAMP(2 + 2 * hh);
            const int hl = w >> 1, h = g * 8 + hh * 4 + hl;
            const float Dh = F.in[6][h];
            const bf16* pvb = prev + ((size_t)((b * NCHK + c) * NH + h) * HD) * NST;
            const LAS float* acsH = acsL + (hh * 4 + hl) * 128; const LAS float* ldaH = ldaL + (hh * 4 + hl) * 128;
            for (int it = 0; it < 2; ++it) {
                SSD_IDS();
                const int ib = (w & 1) ? (1 + it) : (it ? 3 : 0), i = ib * 32 + l31;
                const float ai = acsH[i];
                v2u zz[2][4];
#pragma unroll
                for (int pb = 0; pb < 2; ++pb)
#pragma unroll
                    for (int rg = 0; rg < 4; ++rg) zz[pb][rg] = *(const v2u*)(zx + (row0 + i) * LDZ + h * 64 + pb * 32 + 8 * rg + 4 * h5);
                f32x16 acc[2];
#pragma unroll
                for (int pb = 0; pb < 2; ++pb)
#pragma unroll
                    for (int q = 0; q < 16; ++q) acc[pb][q] = 0.f;
                { bf16x8 pf[8][2];
#pragma unroll
                  for (int ks = 0; ks < 8; ++ks)
#pragma unroll
                      for (int pb = 0; pb < 2; ++pb) pf[ks][pb] = *(const bf16x8*)(pvb + (size_t)(pb * 32 + l31) * NST + 16 * ks + 8 * h5);
                  const float ea = __expf(ai);
#pragma unroll
                  for (int ks = 0; ks < 8; ++ks) { union { bf16x8 v; unsigned u[4]; } cf; cf.v = *(const LAS bf16x8*)(Cn + i * SSD_LS + 16 * ks + 8 * h5);
#pragma unroll
                      for (int q = 0; q < 4; ++q) cf.u[q] = pk2(bflo(cf.u[q]) * ea, bfhi(cf.u[q]) * ea);
#pragma unroll
                      for (int pb = 0; pb < 2; ++pb) acc[pb] = __builtin_amdgcn_mfma_f32_32x32x16_bf16(pf[ks][pb], cf.v, acc[pb], 0, 0, 0); } }
                for (int jb = 0; jb <= ib; ++jb) {
                    f32x16 xa;
#pragma unroll
                    for (int q = 0; q < 16; ++q) xa[q] = 0.f;
                    { bf16x8 bfr[8];
#pragma unroll
                      for (int ks = 0; ks < 8; ++ks) bfr[ks] = *(const LAS bf16x8*)(Bn + (jb * 32 + l31) * SSD_LS + 16 * ks + 8 * h5);
#pragma unroll
                      for (int ks = 0; ks < 8; ++ks) { const bf16x8 cf = *(const LAS bf16x8*)(Cn + i * SSD_LS + 16 * ks + 8 * h5); xa = __builtin_amdgcn_mfma_f32_32x32x16_bf16(bfr[ks], cf, xa, 0, 0, 0); } }
                    float lj[16];
#pragma unroll
                    for (int q = 0; q < 16; ++q) lj[q] = ldaH[jb * 32 + (q & 3) + 8 * (q >> 2) + 4 * h5];
                    const bool diag = (jb == ib);
#pragma unroll
                    for (int q = 0; q < 16; ++q) { const int j = jb * 32 + (q & 3) + 8 * (q >> 2) + 4 * h5; const float v = xa[q] * __expf(ai + lj[q]); xa[q] = (!diag || j <= i) ? v : 0.f; }
#pragma unroll
                    for (int s2 = 0; s2 < 2; ++s2) {
                        union { bf16x8 v; unsigned u[4]; } gf;
#pragma unroll
                        for (int q = 0; q < 4; ++q) gf.u[q] = pk2(xa[8 * s2 + 2 * q], xa[8 * s2 + 2 * q + 1]);
#pragma unroll
                        for (int pb = 0; pb < 2; ++pb) { union { bf16x8 v; v2u hv[2]; } af; const LAS bf16* xp = XT + (hl * 64 + pb * 32 + l31) * SSD_LS + jb * 32 + 16 * s2 + 4 * h5;
                            af.hv[0] = *(const LAS v2u*)xp; af.hv[1] = *(const LAS v2u*)(xp + 8);
                            acc[pb] = __builtin_amdgcn_mfma_f32_32x32x16_bf16(af.v, gf.v, acc[pb], 0, 0, 0); }
                    }
                }
                float ss = 0.f;
#pragma unroll
                for (int pb = 0; pb < 2; ++pb)
#pragma unroll
                    for (int rg = 0; rg < 4; ++rg) { const int p0 = pb * 32 + 8 * rg + 4 * h5;
                        const float zf[4] = {bflo(zz[pb][rg].x), bfhi(zz[pb][rg].x), bflo(zz[pb][rg].y), bfhi(zz[pb][rg].y)}; float yv[4];
#pragma unroll
                        for (int q = 0; q < 4; ++q) { const float xr = bf2f(XT[(hl * 64 + p0 + q) * SSD_LS + i]); const float y = (acc[pb][4 * rg + q] + Dh * xr) * silu_f(zf[q]); yv[q] = y; ss += y * y; }
                        *(v2u*)(yn + (row0 + i) * DIN + h * 64 + p0) = (v2u){pk2(yv[0], yv[1]), pk2(yv[2], yv[3])}; }
                ss += __shfl_xor(ss, 32);
                if (h5 == 0) ssL[(hh * 4 + hl) * 128 + i] = ss;
            }
            SUBSTAMP(3 + 2 * hh);
        }
        asm volatile("s_waitcnt vmcnt(0)" ::: "memory");
        __syncthreads();
        SSD_IDS();
        if (tz_ < 128) { float t = 0.f;
#pragma unroll
            for (int q = 0; q < 8; ++q) t += ssL[q * 128 + tz_];
            acsL[tz_] = 1.0f / sqrtf(t * (1.0f / 512.0f) + LN_EPS); }
        __syncthreads();
        v4u yv[16];
#pragma unroll
        for (int k = 0; k < 16; ++k) { const int q = tz_ + 512 * k; yv[k] = *(const v4u*)(yn + (row0 + (q >> 6)) * DIN + g * 512 + (q & 63) * 8); }
#pragma unroll
        for (int k = 0; k < 16; ++k) { const int q = tz_ + 512 * k, i = q >> 6, ch = g * 512 + (q & 63) * 8; const float rs = acsL[i];
            const f32x4 n0 = *(const f32x4*)(nw + ch), n1 = *(const f32x4*)(nw + ch + 4); v4u v = yv[k];
            v.x = pk2(bflo(v.x) * rs * n0.x, bfhi(v.x) * rs * n0.y); v.y = pk2(bflo(v.y) * rs * n0.z, bfhi(v.y) * rs * n0.w);
            v.z = pk2(bflo(v.z) * rs * n1.x, bfhi(v.z) * rs * n1.y); v.w = pk2(bflo(v.w) * rs * n1.z, bfhi(v.w) * rs * n1.w);
            *(v4u*)(yn + (row0 + i) * DIN + ch) = v; }
        SUBSTAMP(6);
    }
}

#undef SSD_IDS
__device__ __forceinline__ void fast_ln_router(Frame& F, int layer, const float* pre, float* hf, bf16* hb) {
    const float* lg = F.in[20] + (size_t)(layer * 2 + 0) * DM; const float* lb = F.in[21] + (size_t)(layer * 2 + 0) * DM;
    const float* gb = F.in[14] + layer * 4; const float* eb = F.in[16] + layer * 32;
    const bf16* wrh = WSP(bf16, WS_RW) + (size_t)layer * 2 * 48 * DM; const bf16* wrl = wrh + 48 * DM;
    unsigned* cnt = F.ctl + CW_CNT + layer * 64 * 32;
    int* list = WSP(int, WS_LIST); float* glist = WSP(float, WS_GLIST);
    LAS float* statL = (LAS float*)F.lds;
    LAS float* logL = (LAS float*)(F.lds + 1024);
    const int lane = F.lane, w = F.wave, l15 = lane & 15, g4 = lane >> 4, tg = w & 3, half = w >> 2;
    for (int tile = F.bid; tile < MTOK / 64; tile += F.G) {
        const int tok = tile * 64 + tg * 16 + l15, kbase = half * 512 + 8 * g4;
        const float* row = pre + (size_t)tok * DM + kbase;
        float s = 0.f, s2 = 0.f;
#pragma unroll
        for (int ks = 0; ks < 16; ++ks) { const f32x4 a = *(const f32x4*)(row + 32 * ks), c = *(const f32x4*)(row + 32 * ks + 4);
            s += (a.x + a.y) + (a.z + a.w) + (c.x + c.y) + (c.z + c.w);
            s2 += (a.x * a.x + a.y * a.y) + (a.z * a.z + a.w * a.w) + (c.x * c.x + c.y * c.y) + (c.z * c.z + c.w * c.w); }
        s += __shfl_xor(s, 16); s += __shfl_xor(s, 32); s2 += __shfl_xor(s2, 16); s2 += __shfl_xor(s2, 32);
        __syncthreads();
        if (g4 == 0) { statL[(half * 64 + tg * 16 + l15) * 2] = s; statL[(half * 64 + tg * 16 + l15) * 2 + 1] = s2; }
        __syncthreads();
        const float st = statL[(tg * 16 + l15) * 2] + statL[(64 + tg * 16 + l15) * 2], st2 = statL[(tg * 16 + l15) * 2 + 1] + statL[(64 + tg * 16 + l15) * 2 + 1];
        const float mean = st * (1.f / DM), rstd = 1.0f / sqrtf(fmaxf(st2 * (1.f / DM) - mean * mean, 0.f) + LN_EPS);
        f32x4 acc[3];
#pragma unroll
        for (int cb = 0; cb < 3; ++cb) acc[cb] = (f32x4){0.f, 0.f, 0.f, 0.f};
        float* hrow = hf + (size_t)tok * DM + kbase; bf16* brow = hb + (size_t)tok * DM + kbase;
#pragma unroll 4
        for (int ks = 0; ks < 16; ++ks) {
            const f32x4 a = *(const f32x4*)(row + 32 * ks), c = *(const f32x4*)(row + 32 * ks + 4);
            const f32x4 g0 = *(const f32x4*)(lg + kbase + 32 * ks), g1 = *(const f32x4*)(lg + kbase + 32 * ks + 4), b0 = *(const f32x4*)(lb + kbase + 32 * ks), b1 = *(const f32x4*)(lb + kbase + 32 * ks + 4);
            const f32x4 y0 = (a - mean) * rstd * g0 + b0, y1 = (c - mean) * rstd * g1 + b1;
            *(f32x4*)(hrow + 32 * ks) = y0; *(f32x4*)(hrow + 32 * ks + 4) = y1;
            union { bf16x8 v; unsigned u[4]; } hi, lo;
            hi.u[0] = pk2(y0.x, y0.y); hi.u[1] = pk2(y0.z, y0.w); hi.u[2] = pk2(y1.x, y1.y); hi.u[3] = pk2(y1.z, y1.w);
            *(v4u*)(brow + 32 * ks) = (v4u){hi.u[0], hi.u[1], hi.u[2], hi.u[3]};
            lo.u[0] = pk2(y0.x - bflo(hi.u[0]), y0.y - bfhi(hi.u[0])); lo.u[1] = pk2(y0.z - bflo(hi.u[1]), y0.w - bfhi(hi.u[1]));
            lo.u[2] = pk2(y1.x - bflo(hi.u[2]), y1.y - bfhi(hi.u[2])); lo.u[3] = pk2(y1.z - bflo(hi.u[3]), y1.w - bfhi(hi.u[3]));
#pragma unroll
            for (int cb = 0; cb < 3; ++cb) { const size_t wo = (size_t)(cb * 16 + l15) * DM + kbase + 32 * ks;
                const bf16x8 wh = *(const bf16x8*)(wrh + wo), wl = *(const bf16x8*)(wrl + wo);
                acc[cb] = __builtin_amdgcn_mfma_f32_16x16x32_bf16(hi.v, wh, acc[cb], 0, 0, 0);
                acc[cb] = __builtin_amdgcn_mfma_f32_16x16x32_bf16(hi.v, wl, acc[cb], 0, 0, 0);
                acc[cb] = __builtin_amdgcn_mfma_f32_16x16x32_bf16(lo.v, wh, acc[cb], 0, 0, 0); }
        }
#pragma unroll
        for (int cb = 0; cb < 3; ++cb)
#pragma unroll
            for (int q = 0; q < 4; ++q) logL[(half * 64 + tg * 16 + g4 * 4 + q) * 48 + cb * 16 + l15] = acc[cb][q];
        __syncthreads();
        if (F.tid < 64) {
            const int t = F.tid, tk = tile * 64 + t;
            const LAS float* l0 = logL + t * 48; const LAS float* l1 = logL + (64 + t) * 48;
            float gl[4];
#pragma unroll
            for (int q = 0; q < 4; ++q) gl[q] = l0[32 + q] + l1[32 + q] + gb[q];
            int gi = 0; float gm = gl[0];
#pragma unroll
            for (int q = 1; q < 4; ++q) if (gl[q] > gm) { gm = gl[q]; gi = q; }
            float gden = 0.f;
#pragma unroll
            for (int q = 0; q < 4; ++q) gden += __expf(gl[q] - gm);
            const float gval = 1.0f / gden;
            float el[8];
#pragma unroll
            for (int q = 0; q < 8; ++q) el[q] = l0[gi * 8 + q] + l1[gi * 8 + q] + eb[gi * 8 + q];
            int i1 = 0; float v1 = el[0];
#pragma unroll
            for (int q = 1; q < 8; ++q) if (el[q] > v1) { v1 = el[q]; i1 = q; }
            int i2 = -1; float v2 = -3.0e38f;
#pragma unroll
            for (int q = 0; q < 8; ++q) if (q != i1 && el[q] > v2) { v2 = el[q]; i2 = q; }
            const float e2 = __expf(v2 - v1), p1 = gval / (1.0f + e2), p2 = gval * e2 / (1.0f + e2);
            if (i2 < 0) i2 = (i1 + 1) & 7;
            const int ea = gi * 8 + i1, ebx = gi * 8 + i2;
            const unsigned s1 = atomicAdd(cnt + ea * 64, 1u); list[ea * LISTCAP + s1] = tk * 2; glist[ea * LISTCAP + s1] = p1;
            const unsigned s2b = atomicAdd(cnt + ebx * 64, 1u); list[ebx * LISTCAP + s2b] = tk * 2 + 1; glist[ebx * LISTCAP + s2b] = p2;
        }
    }
}

struct Args { const float* in[22]; float* out; unsigned char* ws; int ph_lo, ph_hi; };

__global__ void __launch_bounds__(512, 2) mk_fwd(Args a) {
    extern __shared__ __attribute__((aligned(16))) unsigned char lds_raw[];
    Frame F;
    F.lds = (LAS unsigned char*)lds_raw;
    F.tid = threadIdx.x; F.lane = F.tid & 63; F.wave = __builtin_amdgcn_readfirstlane(F.tid >> 6); F.G = gridDim.x; F.bid = blockIdx.x;
#pragma unroll
    for (int i = 0; i < 22; ++i) F.in[i] = a.in[i];
    F.out = a.out; F.ws = a.ws; F.ctl = (unsigned*)(a.ws + WS_CTL);
    volatile LAS unsigned* MISC = (volatile LAS unsigned*)(F.lds + MISC_OFF);
    if (F.tid < 64) MISC[F.tid] = 0u;
    __syncthreads();
    const bool one_launch = (a.ph_lo == 0 && a.ph_hi == NPH);
    XcdBarrier bar; bar.bar = F.ctl + CW_BAR; bar.x = 0; bar.st = MISC + 8;
    if (one_launch) bar = xcd_barrier_post(F.ctl + CW_BAR, MISC + 8);
    const int lo = a.ph_lo, hi = a.ph_hi;
#define IN(k) (lo <= (k) && (k) < hi)
#define REFRESH() do { int _t = threadIdx.x; asm volatile("" : "+v"(_t)); F.tid = _t; F.lane = _t & 63; } while (0)
#define SEAM(k) do { if (IN(k) && IN((k) + 1)) xcd_barrier(bar); STAMP((k) + 1); } while (0)
    volatile LAS unsigned long long* stampL = (volatile LAS unsigned long long*)(F.lds + MISC_OFF + 1024);
#define STAMP(k) do { if ((PROBE_A >= 0 || PROBE_B >= 0) && F.bid == 0 && F.tid == 0) stampL[k] = wall_clock64(); } while (0)
    STAMP(0);

    if (IN(0)) { REFRESH(); p0_prologue(F); } SEAM(0);
    if (IN(1)) { REFRESH();
        bf16* zx = WSP(bf16, WS_ZX);
        if (FASTP(1)) { { pg8::DenseSched S; S.init(WSP(bf16, WS_XB), WSP(bf16, WS_INWT), MTOK, ZX_DT, DM, F.G, F.bid); pg8::EpiBf16 E{zx, LDZ, 0, 0};
            pg8::gemm_phase<pg8::EpiBf16, pg8::DenseSched, true, true>(F.lds, S, E); } fast_inproj_dt(F); }
        else ref_gemm(F, WSP(bf16, WS_XB), DM, WSP(bf16, WS_INWT), DM, MTOK, LDZ, DM, [=](int m, int n, float v0, float v1) { *(unsigned*)(zx + (size_t)m * LDZ + n) = pk2(v0, v1); });
    } SEAM(1);
    if (IN(2)) { REFRESH(); if (FASTP(2)) fast_ssd_states_phase(F); else for (int u = F.bid; u < BATCH * NCHK * NGRP; u += F.G) ref_ssd_chunk<0>(F, u); } SEAM(2);
    if (IN(3)) { REFRESH(); p3_scan(F); } SEAM(3);
    if (IN(4)) { REFRESH(); if (FASTP(4)) fast_ssd_out_phase(F); else for (int u = F.bid; u < BATCH * NCHK * NGRP; u += F.G) ref_ssd_chunk<1>(F, u); } SEAM(4);
    if (IN(5)) { REFRESH();
        float* pre = WSP(float, WS_PRE1); const float* x = F.in[0];
        if (FASTP(5)) { pg8::DenseSched S; S.init((const bf16*)F.out, WSP(bf16, WS_OUTWT), MTOK, DM, DIN, F.G, F.bid); pg8::EpiResF32 E{pre, x, DM};
            pg8::gemm_phase<pg8::EpiResF32, pg8::DenseSched, false, true>(F.lds, S, E); }
        else ref_gemm(F, (const bf16*)F.out, DIN, WSP(bf16, WS_OUTWT), DIN, MTOK, DM, DIN, [=](int m, int n, float v0, float v1) { const size_t o = (size_t)m * DM + n; pre[o] = DN_ALPHA * x[o] + v0; pre[o + 1] = DN_ALPHA * x[o + 1] + v1; });
    } SEAM(5);
    if (IN(6)) { REFRESH(); if (FASTP(6)) fast_ln_router(F, 0, WSP(float, WS_PRE1), WSP(float, WS_H1), WSP(bf16, WS_HB)); else p_ln_router(F, 0, WSP(float, WS_PRE1), WSP(float, WS_H1), WSP(bf16, WS_HB)); } SEAM(6);
    if (IN(7)) { REFRESH(); if (FASTP(7)) fast_moe_gateup(F, 0); else ref_moe_gateup(F, 0); } SEAM(7);
    if (IN(8)) { REFRESH(); if (FASTP(8)) fast_moe_down(F, 0); else ref_moe_down(F, 0); } SEAM(8);
    if (IN(9)) { REFRESH(); p_ln_ffn(F, 0, WSP(float, WS_H1), WSP(float, WS_H2), WSP(bf16, WS_HB)); } SEAM(9);
    if (IN(10)) { REFRESH();
        bf16* q = WSP(bf16, WS_Q);
        if (FASTP(10)) { pg8::DenseSched S; S.init(WSP(bf16, WS_HB), WSP(bf16, WS_QKVWT), MTOK, 3 * DM, DM, F.G, F.bid); pg8::EpiBf16 E{q, DM, DM, (WS_K - WS_Q) / 2};
            pg8::gemm_phase<pg8::EpiBf16, pg8::DenseSched, true, true>(F.lds, S, E); }
        else ref_gemm(F, WSP(bf16, WS_HB), DM, WSP(bf16, WS_QKVWT), DM, MTOK, 3 * DM, DM, [=](int m, int n, float v0, float v1) { *(unsigned*)(q + (size_t)(n >> 10) * ((WS_K - WS_Q) / 2) + (size_t)m * DM + (n & 1023)) = pk2(v0, v1); });
    } SEAM(10);
    if (IN(11)) { REFRESH(); if (FASTP(11)) fast_attention(F); else ref_attention(F); } SEAM(11);
    if (IN(12)) { REFRESH(); p_attn_rescale(F); } SEAM(12);
    if (IN(13)) { REFRESH();
        float* pre = WSP(float, WS_PRE2); const float* h2 = WSP(float, WS_H2);
        if (FASTP(13)) { pg8::DenseSched S; S.init(WSP(bf16, WS_O), WSP(bf16, WS_OWT), MTOK, DM, DM, F.G, F.bid); pg8::EpiResF32 E{pre, h2, DM};
            pg8::gemm_phase<pg8::EpiResF32, pg8::DenseSched, false, true>(F.lds, S, E); }
        else ref_gemm(F, WSP(bf16, WS_O), DM, WSP(bf16, WS_OWT), DM, MTOK, DM, DM, [=](int m, int n, float v0, float v1) { const size_t o = (size_t)m * DM + n; pre[o] = DN_ALPHA * h2[o] + v0; pre[o + 1] = DN_ALPHA * h2[o + 1] + v1; });
    } SEAM(13);
    if (IN(14)) { REFRESH(); if (FASTP(14)) fast_ln_router(F, 1, WSP(float, WS_PRE2), WSP(float, WS_H1), WSP(bf16, WS_HB)); else p_ln_router(F, 1, WSP(float, WS_PRE2), WSP(float, WS_H1), WSP(bf16, WS_HB)); } SEAM(14);
    if (IN(15)) { REFRESH(); if (FASTP(15)) fast_moe_gateup(F, 1); else ref_moe_gateup(F, 1); } SEAM(15);
    if (IN(16)) { REFRESH(); if (FASTP(16)) fast_moe_down(F, 1); else ref_moe_down(F, 1); } SEAM(16);
    if (IN(17)) { REFRESH(); p_ln_ffn(F, 1, WSP(float, WS_H1), F.out, nullptr); }
    if ((PROBE_A >= 0 || PROBE_B >= 0) && one_launch) {
        asm volatile("s_waitcnt vmcnt(0)" ::: "memory"); __syncthreads();
        STAMP(18);
        if (F.bid == 0 && F.tid == 0) {
            volatile LAS unsigned long long* subL = (volatile LAS unsigned long long*)(F.lds + MISC_OFF + 1536);
            const unsigned da = PROBE_A >= 100 ? (unsigned)(subL[PROBE_A - 99] - subL[PROBE_A - 100]) : (PROBE_A >= 0 ? (unsigned)(stampL[PROBE_A + 1] - stampL[PROBE_A]) : 0u), db = PROBE_B >= 100 ? (unsigned)(subL[PROBE_B - 99] - subL[PROBE_B - 100]) : (PROBE_B >= 0 ? (unsigned)(stampL[PROBE_B + 1] - stampL[PROBE_B]) : 0u);
            __hip_atomic_store(F.ctl + CW_PROBE, da, __ATOMIC_RELAXED, __HIP_MEMORY_SCOPE_AGENT);
            if (PROBE_B >= 0) F.out[0] += (float)db * (PROBE_B >= 100 ? 1.0e-2f : 1.0e-3f);
        }
        xcd_barrier(bar);
        if (PROBE_A >= 0) { const unsigned long long t0 = wall_clock64(); const unsigned long long d = (unsigned long long)PROBE_MULT * __hip_atomic_load(F.ctl + CW_PROBE, __ATOMIC_RELAXED, __HIP_MEMORY_SCOPE_AGENT);
            while (wall_clock64() - t0 < d) __builtin_amdgcn_s_sleep(8); }
    }
#undef IN
#undef SEAM
}

extern "C" void kernel_launch(void* const* d_in, const int* in_sizes, int n_in, void* d_out, int out_size, void* d_ws, size_t ws_size, hipStream_t stream) {
    static int grid = 0;
    if (grid == 0) {
        if (n_in != 22 || out_size != MTOK * DM || ws_size < WS_END) { fprintf(stderr, "kernel_launch: unexpected shapes (n_in %d out %d ws %zu)\n", n_in, out_size, ws_size); grid = -1; return; }
        int dev = 0, cus = 0, per_cu = 0;
        (void)hipGetDevice(&dev); (void)hipDeviceGetAttribute(&cus, hipDeviceAttributeMultiprocessorCount, dev);
        if (hipFuncSetAttribute((const void*)mk_fwd, hipFuncAttributeMaxDynamicSharedMemorySize, LDS_BYTES) != hipSuccess) { fprintf(stderr, "kernel_launch: hipFuncSetAttribute failed\n"); grid = -1; return; }
        (void)hipOccupancyMaxActiveBlocksPerMultiprocessor(&per_cu, (const void*)mk_fwd, 512, LDS_BYTES);
        (void)hipGetLastError();
        if (per_cu < 1) fprintf(stderr, "kernel_launch: occupancy query says %d\n", per_cu);
        grid = cus;
    }
    if (grid < 0) return;
    (void)hipMemsetAsync((char*)d_ws + WS_CTL, 0, CTL_ZERO_BYTES, stream);
    Args a{};
    for (int i = 0; i < 22; ++i) a.in[i] = (const float*)d_in[i];
    a.out = (float*)d_out; a.ws = (unsigned char*)d_ws;
#ifndef MK_PER_PHASE
#define MK_PER_PHASE 0
#endif
    if (MK_PER_PHASE) {
        for (int p = 0; p < NPH; ++p) { a.ph_lo = p; a.ph_hi = p + 1; hipLaunchKernelGGL(mk_fwd, dim3(grid), dim3(512), LDS_BYTES, stream, a); }
    } else {
        a.ph_lo = 0; a.ph_hi = NPH; hipLaunchKernelGGL(mk_fwd, dim3(grid), dim3(512), LDS_BYTES, stream, a);
    }
}
```
